# Optimizing an MI355X kernel written in HIP

```python
import jax, jax.numpy as jnp
from jax import lax
import numpy as np

D_MODEL = 1024
BATCH = 4
SEQ = 4096
DEPTH = 2

N_META = 16
N_MIXERS = 2
SB_HEADS = 16
SB_HEAD_DIM = D_MODEL // SB_HEADS
Q_BLOCK = 128
LRU_WIDTH = D_MODEL
LRU_BLOCKS = 8
LRU_BLOCK_DIM = LRU_WIDTH // LRU_BLOCKS
CONV_WIDTH = 4
LRU_C = 8.0
D_FF = 4 * D_MODEL
EPS = 1e-6
N_SB_LAYERS = (DEPTH + 1) // 2
N_LRU_LAYERS = DEPTH // 2

kernel_name = "hybrid_stickbreak_rglru_meta"


def rms_norm(x, g):
    xf = x.astype(jnp.float32)
    y = xf * lax.rsqrt(jnp.mean(xf * xf, axis=-1, keepdims=True) + EPS)
    return (y * g.astype(jnp.float32)).astype(x.dtype)


def _sb_block(q_blk, k, v, q_pos):
    t_len = k.shape[2]
    k_pos = jnp.arange(t_len)
    z = jnp.einsum('bhqd,bhkd->bhqk', q_blk, k).astype(jnp.float32) * (SB_HEAD_DIM ** -0.5)
    causal = k_pos[None, :] < q_pos[:, None]
    log_keep = jnp.where(causal, -jax.nn.softplus(z), 0.0)
    after = lax.cumsum(log_keep, axis=3, reverse=True) - log_keep
    w = jnp.where(causal, jnp.exp(jax.nn.log_sigmoid(z) + after), 0.0)
    return jnp.einsum('bhqk,bhkd->bhqd', w.astype(v.dtype), v)


def stick_breaking_mixer(x, w_qkv, w_o):
    b, t_len, _ = x.shape
    qkv = (x @ w_qkv).reshape(b, t_len, 3, SB_HEADS, SB_HEAD_DIM).transpose(2, 0, 3, 1, 4)
    q, k, v = qkv[0], qkv[1], qkv[2]
    meta_out = _sb_block(q[:, :, :N_META], k, v, jnp.arange(N_META))
    n_blk = (t_len - N_META) // Q_BLOCK
    q_real = q[:, :, N_META:].reshape(b, SB_HEADS, n_blk, Q_BLOCK, SB_HEAD_DIM).transpose(2, 0, 1, 3, 4)
    pos = N_META + jnp.arange(n_blk * Q_BLOCK).reshape(n_blk, Q_BLOCK)
    real_out = lax.map(lambda a: _sb_block(a[0], k, v, a[1]), (q_real, pos))
    real_out = real_out.transpose(1, 2, 0, 3, 4).reshape(b, SB_HEADS, n_blk * Q_BLOCK, SB_HEAD_DIM)
    o = jnp.concatenate([meta_out, real_out], axis=2)
    o = o.transpose(0, 2, 1, 3).reshape(b, t_len, D_MODEL)
    return o @ w_o


def _lru_combine(left, right):
    a1, b1 = left
    a2, b2 = right
    return a1 * a2, a2 * b1 + b2


def rglru_mixer(x, w_in, conv_w, conv_b, w_rg, b_rg, w_ig, b_ig, lam, w_out):
    b, t_len, _ = x.shape
    gate_in, rec_in = jnp.split(x @ w_in, 2, axis=-1)
    gate = jax.nn.gelu(gate_in)
    xp = jnp.pad(rec_in, ((0, 0), (CONV_WIDTH - 1, 0), (0, 0)))
    u = conv_b + sum(xp[:, j:j + t_len] * conv_w[j] for j in range(CONV_WIDTH))
    ub = u.reshape(b, t_len, LRU_BLOCKS, LRU_BLOCK_DIM)
    r = jax.nn.sigmoid(jnp.einsum('btni,nij->btnj', ub, w_rg).reshape(b, t_len, LRU_WIDTH) + b_rg)
    i = jax.nn.sigmoid(jnp.einsum('btni,nij->btnj', ub, w_ig).reshape(b, t_len, LRU_WIDTH) + b_ig)
    log_a = (-LRU_C * jax.nn.softplus(-lam.astype(jnp.float32))) * r.astype(jnp.float32)
    a = jnp.exp(log_a)
    mult = jnp.sqrt(-jnp.expm1(2.0 * log_a))
    bt = mult * (i * u).astype(jnp.float32)
    _, h = lax.associative_scan(_lru_combine, (a, bt), axis=1)
    y = h.astype(x.dtype) * gate
    return y @ w_out


def sq_relu_mlp(x, w_up, w_down):
    hdn = jax.nn.relu(x @ w_up)
    return (hdn * hdn) @ w_down


def setup_inputs(seed: int = 0) -> dict:
    key = jax.random.key(seed)
    ks = jax.random.split(key, 20)
    f32 = jnp.float32
    D = D_MODEL

    def nrm(k, shape, scale):
        return jax.random.normal(k, shape, f32) * scale

    a0 = jax.random.uniform(ks[11], (N_LRU_LAYERS, LRU_WIDTH), f32, 0.9, 0.999)
    return {
        "x": nrm(ks[0], (BATCH, SEQ, D), 1.0),
        "meta_tokens": nrm(ks[1], (N_META, D), 1.0),
        "norm_mix": 1.0 + nrm(ks[2], (DEPTH, D), 0.02),
        "norm_mlp": 1.0 + nrm(ks[3], (DEPTH, D), 0.02),
        "sb_w_qkv": nrm(ks[4], (N_SB_LAYERS, D, 3 * D), D ** -0.5),
        "sb_w_o": nrm(ks[5], (N_SB_LAYERS, D, D), D ** -0.5),
        "lru_w_in": nrm(ks[6], (N_LRU_LAYERS, D, 2 * LRU_WIDTH), D ** -0.5),
        "lru_conv_w": nrm(ks[7], (N_LRU_LAYERS, CONV_WIDTH, LRU_WIDTH), CONV_WIDTH ** -0.5),
        "lru_conv_b": nrm(ks[8], (N_LRU_LAYERS, LRU_WIDTH), 0.01),
        "lru_w_rg": nrm(ks[9], (N_LRU_LAYERS, LRU_BLOCKS, LRU_BLOCK_DIM, LRU_BLOCK_DIM), LRU_BLOCK_DIM ** -0.5),
        "lru_b_rg": nrm(ks[10], (N_LRU_LAYERS, LRU_WIDTH), 0.01),
        "lru_w_ig": nrm(ks[12], (N_LRU_LAYERS, LRU_BLOCKS, LRU_BLOCK_DIM, LRU_BLOCK_DIM), LRU_BLOCK_DIM ** -0.5),
        "lru_b_ig": nrm(ks[13], (N_LRU_LAYERS, LRU_WIDTH), 0.01),
        "lru_lambda": jnp.log(a0) - jnp.log1p(-a0),
        "lru_w_out": nrm(ks[14], (N_LRU_LAYERS, LRU_WIDTH, D), LRU_WIDTH ** -0.5),
        "mlp_w_up": nrm(ks[15], (DEPTH, D, D_FF), D ** -0.5),
        "mlp_w_down": nrm(ks[16], (DEPTH, D_FF, D), D_FF ** -0.5),
        "norm_final": 1.0 + nrm(ks[17], (D,), 0.02),
    }


def reference(x, meta_tokens, norm_mix, norm_mlp, sb_w_qkv, sb_w_o, lru_w_in, lru_conv_w,
              lru_conv_b, lru_w_rg, lru_b_rg, lru_w_ig, lru_b_ig, lru_lambda, lru_w_out,
              mlp_w_up, mlp_w_down, norm_final):
    b = x.shape[0]
    meta = jnp.broadcast_to(meta_tokens[None].astype(x.dtype), (b, N_META, D_MODEL))
    h = jnp.concatenate([meta, x], axis=1)
    for i in range(DEPTH):
        hn = rms_norm(h, norm_mix[i])
        j = i // N_MIXERS
        if i % N_MIXERS == 0:
            h = h + stick_breaking_mixer(hn, sb_w_qkv[j], sb_w_o[j])
        else:
            h = h + rglru_mixer(hn, lru_w_in[j], lru_conv_w[j], lru_conv_b[j], lru_w_rg[j],
                                lru_b_rg[j], lru_w_ig[j], lru_b_ig[j], lru_lambda[j], lru_w_out[j])
        hn = rms_norm(h, norm_mlp[i])
        h = h + sq_relu_mlp(hn, mlp_w_up[i], mlp_w_down[i])
    h = rms_norm(h, norm_final)
    return h[:, N_META:]
```

```cpp
#include <hip/hip_runtime.h>
#include <hip/hip_cooperative_groups.h>
#include <cstdio>
#include <cstdint>
namespace cg = cooperative_groups;
namespace pg8 {
#define PG8_LAS __attribute__((address_space(3)))
typedef unsigned short bf16_t;
typedef short bf16x8 __attribute__((ext_vector_type(8)));
typedef float f32x4 __attribute__((ext_vector_type(4)));
typedef unsigned u32x4 __attribute__((ext_vector_type(4)));
constexpr int BM = 256, BK = 64, HALF = 128, HTB = HALF * BK * 2  , STAGE_BYTES = 8 * HTB, NXCD = 8, WGM = 8;

__host__ __device__ __forceinline__ int lds_byte(int r, int c) { const int st = (r >> 4) * 2 + (c >> 5), rr = r & 15, cc = c & 31, ob = rr * 64 + cc * 2; return st * 1024 + (ob ^ (((ob >> 9) & 1) << 5)); }
__host__ __device__ __forceinline__ void stage_rc(int b, int& R, int& C) { const int st = b / 1024, sb = b % 1024, swz = sb ^ (((sb >> 9) & 1) << 5); R = (st >> 1) * 16 + swz / 64; C = (st & 1) * 32 + (swz % 64) / 2; }
__host__ __device__ __forceinline__ int perm32(int rho) { const int n = rho >> 4, i = rho & 15; return 8 * (i >> 2) + 4 * n + (i & 3); }

struct Unit { int pm, pn; };
struct Gemm { const bf16_t* A; const bf16_t* Bt; int M, N, K, lda, ldb; };

struct StaticOrder {
    int nM, nN, nwg, G, c;
    __host__ __device__ void init(int M, int N, int G_, int c_) { nM = M / BM; nN = N / BM; nwg = nM * nN; G = G_; c = c_; }
    __host__ __device__ bool next(int i, Unit& u) const {
        const long L = (long)i * G + c; if (L >= nwg) return false;
        int wgid = (int)L; { const int q = nwg / NXCD, r = nwg % NXCD, xcd = wgid % NXCD, off = wgid / NXCD; wgid = (xcd < r ? xcd * (q + 1) : r * (q + 1) + (xcd - r) * q) + off; }
        const int nig = WGM * nN, gid = wgid / nig, fm = gid * WGM, gsz = (nM - fm) < WGM ? (nM - fm) : WGM;
        u.pm = fm + ((wgid % nig) % gsz); u.pn = (wgid % nig) / gsz; return true;
    }
    __device__ __forceinline__ void a_ready(const Unit&) const {}
    __device__ __forceinline__ void done(const Unit&) const {}
};

__device__ __forceinline__ unsigned cvt_pk_bf16(float lo, float hi) { unsigned r; asm volatile("v_cvt_pk_bf16_f32 %0, %1, %2" : "=v"(r) : "v"(lo), "v"(hi)); return r; }
typedef float f32x2 __attribute__((ext_vector_type(2)));
typedef unsigned u32x2 __attribute__((ext_vector_type(2)));
__device__ __forceinline__ void st16_wt(void* p, u32x4 v) { asm volatile("global_store_dwordx4 %0, %1, off sc1\n\ts_nop 1" :: "v"(p), "v"(v) : "memory"); }
constexpr int PP = 4128;
constexpr float EPSN = 1e-6f;
constexpr int ACT_LD = 4160;
__device__ __forceinline__ float rstd_of(float ss) { return rsqrtf(ss * (1.0f / 1024.0f) + EPSN); }
struct EpiQKV {
    static constexpr bool PERM = true, AFTER_DRAIN = false;
    bf16_t* Q; bf16_t* Kb; bf16_t* Vt; const float* rowss; float qscale; const PG8_LAS float* rst; int nrst; PG8_LAS unsigned char* tl; mutable int ui = 0;
    __device__ __forceinline__ void operator()(const f32x4 (&acc)[2][2][4][2], const Unit& u, int wr, int wc, int fr, int fq) const {
        const int colt = u.pn * BM; const int which = colt >> 10; const int cbase = (colt & 1023) + wc * 32 + 8 * fq;
#pragma unroll
        for (int ai = 0; ai < 2; ++ai)
#pragma unroll
            for (int m = 0; m < 4; ++m) {
                const int row = u.pm * BM + ai * HALF + wr * 64 + m * 16 + fr;
                const int b = row >> 12, pos = (row & 4095) + 16;
                float rs = rst[ui * 256 + ai * HALF + wr * 64 + m * 16 + fr]; if (which == 0) rs *= qscale;
#pragma unroll
                for (int bj = 0; bj < 2; ++bj) {
                    const int c = cbase + bj * HALF; const int head = c >> 6, d = c & 63;
                    const f32x4 v0 = acc[ai][bj][m][0] * rs, v1 = acc[ai][bj][m][1] * rs;
                    u32x4 w; w.x = cvt_pk_bf16(v0[0], v0[1]); w.y = cvt_pk_bf16(v0[2], v0[3]); w.z = cvt_pk_bf16(v1[0], v1[1]); w.w = cvt_pk_bf16(v1[2], v1[3]);
                    if (which < 2) {
                        bf16_t* dst = (which == 0 ? Q : Kb) + ((size_t)((b * 16 + head) * PP + pos)) * 64 + d;
                        *(u32x4*)dst = w;
                    } else {
                        PG8_LAS bf16_t* T = (PG8_LAS bf16_t*)(tl + (wr * 4 + wc) * 1536);
                        const int rb = 8 * fq * 24 + fr;
                        T[rb] = (bf16_t)(w.x & 0xffffu); T[rb + 24] = (bf16_t)(w.x >> 16); T[rb + 48] = (bf16_t)(w.y & 0xffffu); T[rb + 72] = (bf16_t)(w.y >> 16);
                        T[rb + 96] = (bf16_t)(w.z & 0xffffu); T[rb + 120] = (bf16_t)(w.z >> 16); T[rb + 144] = (bf16_t)(w.w & 0xffffu); T[rb + 168] = (bf16_t)(w.w >> 16);
                        const int L = fq * 16 + fr, dl = L >> 1, hf = L & 1;
                        const u32x4 tv = *(const PG8_LAS u32x4*)(T + dl * 24 + hf * 8);
                        const int pos0 = ((u.pm * BM + ai * HALF + wr * 64 + m * 16) & 4095) + 16;
                        const int dbase = (c & 63) - 8 * fq;
                        *(u32x4*)(Vt + ((size_t)((b * 16 + head) * 64 + dbase + dl)) * PP + pos0 + 8 * hf) = tv;
                    }
                }
            }
        ++ui;
    }
};
__device__ __forceinline__ float bflo(unsigned w) { return __builtin_bit_cast(float, w << 16); }
__device__ __forceinline__ float bfhi(unsigned w) { return __builtin_bit_cast(float, w & 0xffff0000u); }
struct EpiResid {
    static constexpr bool PERM = true, AFTER_DRAIN = false;
    bf16_t* hb; float* rowss_out;
    __device__ __forceinline__ void operator()(const f32x4 (&acc)[2][2][4][2], const Unit& u, int wr, int wc, int fr, int fq) const {
        const int col0 = u.pn * BM + wc * 32 + 8 * fq;
        u32x4 old[2][4][2];
#pragma unroll
        for (int ai = 0; ai < 2; ++ai)
#pragma unroll
            for (int m = 0; m < 4; ++m)
#pragma unroll
                for (int bj = 0; bj < 2; ++bj) old[ai][m][bj] = *(const u32x4*)(hb + (size_t)(u.pm * BM + ai * HALF + wr * 64 + m * 16 + fr) * 1024 + col0 + bj * HALF);
#pragma unroll
        for (int ai = 0; ai < 2; ++ai)
#pragma unroll
            for (int m = 0; m < 4; ++m) {
                const int row = u.pm * BM + ai * HALF + wr * 64 + m * 16 + fr; float ss = 0.f;
#pragma unroll
                for (int bj = 0; bj < 2; ++bj) {
                    const u32x4 ov = old[ai][m][bj]; const f32x4 a0 = acc[ai][bj][m][0], a1 = acc[ai][bj][m][1];
                    u32x4 w;
                    w.x = cvt_pk_bf16(bflo(ov.x) + a0[0], bfhi(ov.x) + a0[1]); w.y = cvt_pk_bf16(bflo(ov.y) + a0[2], bfhi(ov.y) + a0[3]);
                    w.z = cvt_pk_bf16(bflo(ov.z) + a1[0], bfhi(ov.z) + a1[1]); w.w = cvt_pk_bf16(bflo(ov.w) + a1[2], bfhi(ov.w) + a1[3]);
                    *(u32x4*)(hb + (size_t)row * 1024 + col0 + bj * HALF) = w;
#pragma unroll
                    for (int e = 0; e < 4; ++e) { const float lo = bflo(w[e]), hi = bfhi(w[e]); ss += lo * lo + hi * hi; }
                }
                ss += __shfl_xor(ss, 16); ss += __shfl_xor(ss, 32);
                if (fq == 0) atomicAdd(rowss_out + row, ss);
            }
    }
};
struct EpiFinal {
    static constexpr bool PERM = false, AFTER_DRAIN = true;
    const bf16_t* hb; float* rowss; float* out; const float* gfin; unsigned* cnt;
    __device__ __forceinline__ void fused(f32x4 (&acc)[2][2][4][2], const Unit& u, int wr, int wc, int fr, int fq, PG8_LAS unsigned char* lds, int wid, int lane) const {
        const int col0 = u.pn * BM + wc * 32 + 4 * fq;
        u32x2 old[2][4][2][2];
#pragma unroll
        for (int ai = 0; ai < 2; ++ai)
#pragma unroll
            for (int m = 0; m < 4; ++m)
#pragma unroll
                for (int bj = 0; bj < 2; ++bj)
#pragma unroll
                    for (int n = 0; n < 2; ++n) old[ai][m][bj][n] = *(const u32x2*)(hb + (size_t)(u.pm * BM + ai * HALF + wr * 64 + m * 16 + fr) * 1024 + col0 + bj * HALF + n * 16);
        f32x4 gv[2][2];
#pragma unroll
        for (int bj = 0; bj < 2; ++bj)
#pragma unroll
            for (int n = 0; n < 2; ++n) gv[bj][n] = *(const f32x4*)(gfin + col0 + bj * HALF + n * 16);
#pragma unroll
        for (int ai = 0; ai < 2; ++ai)
#pragma unroll
            for (int m = 0; m < 4; ++m) {
                const int row = u.pm * BM + ai * HALF + wr * 64 + m * 16 + fr; float ss = 0.f;
#pragma unroll
                for (int bj = 0; bj < 2; ++bj)
#pragma unroll
                    for (int n = 0; n < 2; ++n) { const u32x2 ov = old[ai][m][bj][n]; f32x4 v = acc[ai][bj][m][n];
                        v[0] += bflo(ov.x); v[1] += bfhi(ov.x); v[2] += bflo(ov.y); v[3] += bfhi(ov.y); acc[ai][bj][m][n] = v;
                        ss += (v[0] * v[0] + v[1] * v[1]) + (v[2] * v[2] + v[3] * v[3]); }
                ss += __shfl_xor(ss, 16); ss += __shfl_xor(ss, 32);
                if (fq == 0) __hip_atomic_fetch_add(rowss + row, ss, __ATOMIC_RELAXED, __HIP_MEMORY_SCOPE_AGENT);
            }
        asm volatile("s_waitcnt vmcnt(0)" ::: "memory");
        asm volatile("s_barrier" ::: "memory");
        if (wid == 0 && lane == 0) {
            __hip_atomic_fetch_add(cnt + u.pm, 1u, __ATOMIC_RELAXED, __HIP_MEMORY_SCOPE_AGENT);
            unsigned spins = 0;
            while (__hip_atomic_load(cnt + u.pm, __ATOMIC_RELAXED, __HIP_MEMORY_SCOPE_AGENT) < 4u) { __builtin_amdgcn_s_sleep(2); if (++spins > (1u << 22)) break; }
        }
        asm volatile("s_waitcnt vmcnt(0) lgkmcnt(0)\n\ts_barrier" ::: "memory");
        float ssv[2][4];
#pragma unroll
        for (int ai = 0; ai < 2; ++ai)
#pragma unroll
            for (int m = 0; m < 4; ++m) ssv[ai][m] = __hip_atomic_load(rowss + u.pm * BM + ai * HALF + wr * 64 + m * 16 + fr, __ATOMIC_RELAXED, __HIP_MEMORY_SCOPE_AGENT);
#pragma unroll
        for (int ai = 0; ai < 2; ++ai)
#pragma unroll
            for (int m = 0; m < 4; ++m) {
                const int row = u.pm * BM + ai * HALF + wr * 64 + m * 16 + fr;
                const float rs = rstd_of(ssv[ai][m]);
#pragma unroll
                for (int bj = 0; bj < 2; ++bj)
#pragma unroll
                    for (int n = 0; n < 2; ++n) *(f32x4*)(out + (size_t)row * 1024 + col0 + bj * HALF + n * 16) = acc[ai][bj][m][n] * rs * gv[bj][n];
            }
    }
};
struct EpiUp {
    static constexpr bool PERM = true, AFTER_DRAIN = false;
    bf16_t* O; const float* rowss; const PG8_LAS float* rst; int nrst; mutable int ui = 0;
    __device__ __forceinline__ void operator()(const f32x4 (&acc)[2][2][4][2], const Unit& u, int wr, int wc, int fr, int fq) const {
        const int col0 = u.pn * BM + wc * 32 + 8 * fq;
#pragma unroll
        for (int ai = 0; ai < 2; ++ai)
#pragma unroll
            for (int m = 0; m < 4; ++m) {
                const int row = u.pm * BM + ai * HALF + wr * 64 + m * 16 + fr; const float rs = rst[ui * 256 + ai * HALF + wr * 64 + m * 16 + fr];
#pragma unroll
                for (int bj = 0; bj < 2; ++bj) {
                    f32x4 v0 = acc[ai][bj][m][0] * rs, v1 = acc[ai][bj][m][1] * rs;
#pragma unroll
                    for (int e = 0; e < 4; ++e) { const float a = fmaxf(v0[e], 0.f), b = fmaxf(v1[e], 0.f); v0[e] = a * a; v1[e] = b * b; }
                    u32x4 w; w.x = cvt_pk_bf16(v0[0], v0[1]); w.y = cvt_pk_bf16(v0[2], v0[3]); w.z = cvt_pk_bf16(v1[0], v1[1]); w.w = cvt_pk_bf16(v1[2], v1[3]);
                    st16_wt(O + (size_t)row * ACT_LD + col0 + bj * HALF, w);
                }
            }
        ++ui;
    }
};
__device__ __forceinline__ float gelu_tanh(float x) {
    const float y = 0.7978845608028654f * (x + 0.044715f * x * x * x);
    return x * __builtin_amdgcn_rcpf(1.0f + __builtin_amdgcn_exp2f(-2.0f * 1.4426950408889634f * y));
}
struct EpiWin {
    static constexpr bool PERM = true, AFTER_DRAIN = false;
    bf16_t* G; bf16_t* R; const float* rowss; const PG8_LAS float* rst; int nrst; mutable int ui = 0;
    __device__ __forceinline__ void operator()(const f32x4 (&acc)[2][2][4][2], const Unit& u, int wr, int wc, int fr, int fq) const {
        const int colt = u.pn * BM; const bool isgate = colt < 1024; const int col0 = (colt & 1023) + wc * 32 + 8 * fq; bf16_t* dstb = isgate ? G : R;
#pragma unroll
        for (int ai = 0; ai < 2; ++ai)
#pragma unroll
            for (int m = 0; m < 4; ++m) {
                const int row = u.pm * BM + ai * HALF + wr * 64 + m * 16 + fr; const float rs = rst[ui * 256 + ai * HALF + wr * 64 + m * 16 + fr];
#pragma unroll
                for (int bj = 0; bj < 2; ++bj) {
                    f32x4 v0 = acc[ai][bj][m][0] * rs, v1 = acc[ai][bj][m][1] * rs;
                    if (isgate) {
#pragma unroll
                        for (int e = 0; e < 4; ++e) { v0[e] = gelu_tanh(v0[e]); v1[e] = gelu_tanh(v1[e]); }
                    }
                    u32x4 w; w.x = cvt_pk_bf16(v0[0], v0[1]); w.y = cvt_pk_bf16(v0[2], v0[3]); w.z = cvt_pk_bf16(v1[0], v1[1]); w.w = cvt_pk_bf16(v1[2], v1[3]);
                    *(u32x4*)(dstb + (size_t)row * 1024 + col0 + bj * HALF) = w;
                }
            }
        ++ui;
    }
};
template <class Epi, class Sched, bool ALIGN_EPI = false, bool SP2 = false>
__device__ __forceinline__ void gemm_phase(PG8_LAS unsigned char* lds, const Gemm g, const Sched& S, const Epi& E) {
    const int tid = threadIdx.x, wid = __builtin_amdgcn_readfirstlane(tid >> 6), lane = tid & 63, wr = wid >> 2, wc = wid & 3, fr = lane & 15, fq = lane >> 4;
    const int K = g.K, nt = K / BK;
    unsigned voffA[2], voffB[2];
#pragma unroll
    for (int i = 0; i < 2; ++i) { int R, C; stage_rc(tid * 16 + i * 8192, R, C); const int Rb = Epi::PERM ? ((R & ~31) + perm32(R & 31)) : R;
        voffA[i] = (unsigned)(R * g.lda + C) * 2u; voffB[i] = (unsigned)(Rb * g.ldb + C) * 2u; }
    const size_t kstep = (size_t)(BK * 2);
    const size_t hstepA = (size_t)HALF * g.lda * 2, hstepB = (size_t)HALF * g.ldb * 2;
    const size_t tstepA = 2 * hstepA, tstepB = 2 * hstepB;
    const unsigned ldsw = (unsigned)wid * 1024u;
    const int aoff = lds_byte(wr * 64 + fr, fq * 8), boff = lds_byte(wc * 32 + fr, fq * 8);
#define PG8_SA(b, h) (((b) * 2 + (h)) * HTB)
#define PG8_SB(b, h) ((4 + (b) * 2 + (h)) * HTB)
#define PG8_STAGE(bufoff, gbase, voff) do { _Pragma("unroll") for (int _i = 0; _i < 2; ++_i) \
        __builtin_amdgcn_global_load_lds((const unsigned*)((const char*)(gbase) + (voff)[_i]), (PG8_LAS unsigned*)(lds + (bufoff) + ldsw + _i * 8192), 16, 0, 0); } while (0)
#define PG8_LDA(dst, b, h) do { _Pragma("unroll") for (int m = 0; m < 4; ++m) _Pragma("unroll") for (int k = 0; k < 2; ++k) dst[m][k] = *(const PG8_LAS bf16x8*)(lds + PG8_SA(b, h) + aoff + m * 2048 + k * 1024); } while (0)
#define PG8_LDB(dst, b, h) do { _Pragma("unroll") for (int n = 0; n < 2; ++n) _Pragma("unroll") for (int k = 0; k < 2; ++k) dst[n][k] = *(const PG8_LAS bf16x8*)(lds + PG8_SB(b, h) + boff + n * 2048 + k * 1024); } while (0)
#define PG8_MMA(ai, bj, At, Bt) do { __builtin_amdgcn_s_setprio(1); _Pragma("unroll") for (int m = 0; m < 4; ++m) _Pragma("unroll") for (int n = 0; n < 2; ++n) _Pragma("unroll") for (int k = 0; k < 2; ++k) \
        acc[ai][bj][m][n] = __builtin_amdgcn_mfma_f32_16x16x32_bf16(Bt[n][k], At[m][k], acc[ai][bj][m][n], 0, 0, 0); __builtin_amdgcn_s_setprio(0); } while (0)
#define PG8_WAIT_V(n) asm volatile("s_waitcnt vmcnt(" #n ")" ::: "memory")
#define PG8_WAIT_L(n) asm volatile("s_waitcnt lgkmcnt(" #n ")" ::: "memory")
#define PG8_BAR __builtin_amdgcn_s_barrier()
#define PG8_SCHED __builtin_amdgcn_sched_barrier(0)
    Unit cur, nxt; int ui = 0;
    if (!S.next(0, cur)) return;
    f32x4 acc[2][2][4][2];
#pragma unroll
    for (int a = 0; a < 2; ++a)
#pragma unroll
        for (int b = 0; b < 2; ++b)
#pragma unroll
            for (int m = 0; m < 4; ++m)
#pragma unroll
                for (int n = 0; n < 2; ++n) acc[a][b][m][n] = (f32x4){0.f, 0.f, 0.f, 0.f};
    bf16x8 At[4][2], B0[2][2], B1[2][2];
    const char* cA = (const char*)g.A + (size_t)cur.pm * tstepA; const char* cB = (const char*)g.Bt + (size_t)cur.pn * tstepB;
    S.a_ready(cur);
    if constexpr (SP2) {
        PG8_STAGE(PG8_SB(0, 0), cB, voffB); PG8_STAGE(PG8_SB(0, 1), cB + hstepB, voffB); PG8_STAGE(PG8_SA(0, 0), cA, voffA); PG8_STAGE(PG8_SA(0, 1), cA + hstepA, voffA);
        if (wr == 1) PG8_BAR;
        PG8_WAIT_V(2); PG8_BAR;
        PG8_STAGE(PG8_SB(1, 0), cB + kstep, voffB); PG8_STAGE(PG8_SA(1, 0), cA + kstep, voffA); PG8_STAGE(PG8_SB(1, 1), cB + hstepB + kstep, voffB);
        PG8_WAIT_V(6); PG8_BAR;
    } else {
        PG8_STAGE(PG8_SB(0, 0), cB, voffB); PG8_STAGE(PG8_SA(0, 0), cA, voffA); PG8_STAGE(PG8_SB(0, 1), cB + hstepB, voffB); PG8_STAGE(PG8_SA(0, 1), cA + hstepA, voffA);
        if (wr == 1) PG8_BAR;
        PG8_WAIT_V(4); PG8_BAR;
        PG8_STAGE(PG8_SB(1, 0), cB + kstep, voffB); PG8_STAGE(PG8_SA(1, 0), cA + kstep, voffA); PG8_STAGE(PG8_SB(1, 1), cB + hstepB + kstep, voffB);
        PG8_WAIT_V(6); PG8_BAR;
    }
    for (;;) {
        const bool has_next = S.next(ui + 1, nxt);
        const char* nA = has_next ? (const char*)g.A + (size_t)nxt.pm * tstepA : cA; const char* nB = has_next ? (const char*)g.Bt + (size_t)nxt.pn * tstepB : cB;
        for (int t = 0; t < nt; t += 2) {
            const bool last = (t == nt - 2);
            const char* a1 = cA + (size_t)(t + 1) * kstep;
            const char* a2 = last ? nA : cA + (size_t)(t + 2) * kstep; const char* b2 = last ? nB : cB + (size_t)(t + 2) * kstep;
            const char* a3 = a2 + kstep; const char* b3 = b2 + kstep;
            if (last && has_next) S.a_ready(nxt);
            if constexpr (SP2) {
            PG8_LDB(B0, 0, 0); PG8_LDB(B1, 0, 1); PG8_SCHED; PG8_LDA(At, 0, 0); PG8_STAGE(PG8_SA(1, 1), a1 + hstepA, voffA);
            PG8_WAIT_V(8); PG8_WAIT_L(0); PG8_BAR; PG8_MMA(0, 0, At, B0); PG8_MMA(0, 1, At, B1); PG8_BAR; PG8_SCHED;
            PG8_LDA(At, 0, 1); PG8_STAGE(PG8_SB(0, 0), b2, voffB); PG8_STAGE(PG8_SB(0, 1), b2 + hstepB, voffB); PG8_STAGE(PG8_SA(0, 0), a2, voffA);
            PG8_WAIT_V(8); PG8_WAIT_L(0); PG8_BAR; PG8_MMA(1, 0, At, B0); PG8_MMA(1, 1, At, B1); PG8_BAR; PG8_SCHED;
            PG8_LDB(B0, 1, 0); PG8_LDB(B1, 1, 1); PG8_SCHED; PG8_LDA(At, 1, 0); PG8_STAGE(PG8_SA(0, 1), a2 + hstepA, voffA);
            PG8_WAIT_V(8); PG8_WAIT_L(0); PG8_BAR; PG8_MMA(0, 0, At, B0); PG8_MMA(0, 1, At, B1); PG8_BAR; PG8_SCHED;
            PG8_LDA(At, 1, 1); PG8_STAGE(PG8_SB(1, 0), b3, voffB); PG8_STAGE(PG8_SB(1, 1), b3 + hstepB, voffB); PG8_STAGE(PG8_SA(1, 0), a3, voffA);
            PG8_WAIT_V(8); PG8_WAIT_L(0); PG8_BAR; PG8_MMA(1, 0, At, B0); PG8_MMA(1, 1, At, B1); PG8_BAR; PG8_SCHED;
            } else {
            PG8_LDB(B0, 0, 0); PG8_SCHED; PG8_LDA(At, 0, 0); PG8_STAGE(PG8_SA(1, 1), a1 + hstepA, voffA);
            PG8_WAIT_L(8); PG8_BAR; PG8_WAIT_L(0); PG8_MMA(0, 0, At, B0); PG8_BAR; PG8_SCHED;
            PG8_LDB(B1, 0, 1); PG8_STAGE(PG8_SB(0, 0), b2, voffB);
            PG8_BAR; PG8_WAIT_L(0); PG8_MMA(0, 1, At, B1); PG8_BAR;
            PG8_LDA(At, 0, 1); PG8_STAGE(PG8_SA(0, 0), a2, voffA);
            PG8_BAR; PG8_WAIT_L(0); PG8_MMA(1, 0, At, B0); PG8_BAR; PG8_SCHED;
            PG8_STAGE(PG8_SB(0, 1), b2 + hstepB, voffB);
            PG8_WAIT_V(6); PG8_BAR; PG8_MMA(1, 1, At, B1); PG8_BAR;
            PG8_LDB(B0, 1, 0); PG8_SCHED; PG8_LDA(At, 1, 0); PG8_STAGE(PG8_SA(0, 1), a2 + hstepA, voffA);
            PG8_WAIT_L(8); PG8_BAR; PG8_WAIT_L(0); PG8_MMA(0, 0, At, B0); PG8_BAR; PG8_SCHED;
            PG8_LDB(B1, 1, 1); PG8_STAGE(PG8_SB(1, 0), b3, voffB);
            PG8_BAR; PG8_WAIT_L(0); PG8_MMA(0, 1, At, B1); PG8_BAR;
            PG8_LDA(At, 1, 1); PG8_STAGE(PG8_SA(1, 0), a3, voffA);
            PG8_BAR; PG8_WAIT_L(0); PG8_MMA(1, 0, At, B0); PG8_BAR; PG8_SCHED;
            PG8_STAGE(PG8_SB(1, 1), b3 + hstepB, voffB);
            PG8_WAIT_V(6); PG8_BAR; PG8_MMA(1, 1, At, B1); PG8_BAR;
            }
        }
        if constexpr (ALIGN_EPI) { if (wr == 0) PG8_BAR; }
        if constexpr (!Epi::AFTER_DRAIN) { E(acc, cur, wr, wc, fr, fq); S.done(cur); }
        if (!has_next) break;
#pragma unroll
        for (int a = 0; a < 2; ++a)
#pragma unroll
            for (int b = 0; b < 2; ++b)
#pragma unroll
                for (int m = 0; m < 4; ++m)
#pragma unroll
                    for (int n = 0; n < 2; ++n) acc[a][b][m][n] = (f32x4){0.f, 0.f, 0.f, 0.f};
        cur = nxt; cA = nA; cB = nB; ++ui;
        if constexpr (ALIGN_EPI) { if (wr == 1) PG8_BAR; }
    }
    PG8_WAIT_V(0);
    if constexpr (!ALIGN_EPI) { if (wr == 0) PG8_BAR; }
    PG8_BAR;
    if constexpr (Epi::AFTER_DRAIN) { E.fused(acc, cur, wr, wc, fr, fq, lds, wid, lane); S.done(cur); }
#undef PG8_SA
#undef PG8_SB
#undef PG8_STAGE
#undef PG8_LDA
#undef PG8_LDB
#undef PG8_MMA
#undef PG8_WAIT_V
#undef PG8_WAIT_L
#undef PG8_BAR
#undef PG8_SCHED
}
}
#define LAS __attribute__((address_space(3)))
typedef unsigned short bf16;
typedef float f32x4 __attribute__((ext_vector_type(4)));
typedef float f32x16 __attribute__((ext_vector_type(16)));
typedef short bf16x8 __attribute__((ext_vector_type(8)));
typedef unsigned u32x4 __attribute__((ext_vector_type(4)));
typedef unsigned u32x2 __attribute__((ext_vector_type(2)));
constexpr int NWAVES = 8, NTHREADS = 512;
constexpr int NREAL = 16384, MBASE = 16384, MALLOC = 16448, DM = 1024, FF = 4096, PP = pg8::PP;
constexpr float QSCALE = 0.125f * 1.4426950408889634f;
constexpr size_t MiB = 1u << 20;
constexpr size_t WS_ROWSS = 0;
constexpr size_t WS_HMETA = 512 * 1024;
constexpr size_t WS_HMEND = 640 * 1024;
constexpr size_t WS_PCNT = 704 * 1024;
constexpr size_t WS_SFLAG = 736 * 1024;
constexpr size_t WS_BAR = 768 * 1024;
constexpr size_t WS_CARA = 1 * MiB, WS_CARB = 2 * MiB;
constexpr int ACT_LD = pg8::ACT_LD;
constexpr size_t KiB256 = 256 * 1024;
constexpr size_t WS_WQKV = 4 * MiB, WS_WO = 10 * MiB, WS_WUP0 = 12 * MiB, WS_WDN0 = 20 * MiB, WS_WIN = 28 * MiB + KiB256, WS_WRG = 32 * MiB + KiB256, WS_WIG = 32 * MiB + 2 * KiB256,
                 WS_WOUT = 33 * MiB + KiB256, WS_WUP1 = 35 * MiB + KiB256, WS_WDN1 = 43 * MiB + KiB256;
static_assert(WS_WDN0 + (size_t)1024 * ACT_LD * 2 <= WS_WIN && WS_WDN1 + (size_t)1024 * ACT_LD * 2 <= 52 * MiB, "weight map");
constexpr size_t WS_HB = 52 * MiB;
constexpr size_t WS_A = 85 * MiB;
constexpr size_t QKV_BYTES = (size_t)64 * PP * 64 * 2;
constexpr size_t ROWARR = (size_t)MALLOC * 1024 * 2;
constexpr size_t WS_Q = WS_A, WS_K = WS_A + QKV_BYTES, WS_VT = WS_A + 2 * QKV_BYTES, WS_O = WS_A + 3 * QKV_BYTES;
constexpr size_t WS_ACT = WS_A;
constexpr size_t WS_GATE = WS_A, WS_REC = WS_A + ROWARR, WS_HL = WS_A + 2 * ROWARR, WS_PC = WS_A + 3 * ROWARR;
constexpr size_t WS_Y = 216 * MiB;
constexpr size_t WS_END = WS_Y + ROWARR;
static_assert(WS_O + ROWARR <= WS_Y && WS_ACT + (size_t)(MBASE + 16) * ACT_LD * 2 <= WS_Y && WS_PC + ROWARR <= WS_Y && WS_END <= 256 * MiB, "ws map");
constexpr int LDS_BYTES = 163840;

struct Args {
    const float* in[18]; float* out; unsigned char* ws; int ph_lo, ph_hi;
};

__device__ __forceinline__ unsigned f2bf(float f) { unsigned u = __builtin_bit_cast(unsigned, f); return (u + 0x7fffu + ((u >> 16) & 1u)) >> 16; }
__device__ __forceinline__ unsigned pk2(float lo, float hi) { return f2bf(lo) | (f2bf(hi) << 16); }
__device__ __forceinline__ float bf2f(unsigned short v) { return __builtin_bit_cast(float, (unsigned)v << 16); }
__device__ __forceinline__ float wave_sum(float v) {
#pragma unroll
    for (int o = 1; o < 64; o <<= 1) v += __shfl_xor(v, o);
    return v;
}
__device__ __forceinline__ void p0_transpose_item(const float* W, int K, int N, bf16* WT, const float* gain, float* scr, int item, int lane, int ldt = 0) {
    if (ldt == 0) ldt = K;
    const int nblk = N / 32, kb = item / nblk, nb = item % nblk, k0 = 64 * kb, n0 = 32 * nb;
    {
        const int rr = lane >> 3, c4 = (lane & 7) * 4;
        f32x4 v[8];
#pragma unroll
        for (int i = 0; i < 8; ++i) v[i] = *(const f32x4*)(W + (size_t)(k0 + 8 * i + rr) * N + n0 + c4);
#pragma unroll
        for (int i = 0; i < 8; ++i) { const int kk = 8 * i + rr; const float gk = gain ? gain[k0 + kk] : 1.0f;
            scr[kk * 33 + c4] = v[i][0] * gk; scr[kk * 33 + c4 + 1] = v[i][1] * gk; scr[kk * 33 + c4 + 2] = v[i][2] * gk; scr[kk * 33 + c4 + 3] = v[i][3] * gk; }
    }
    asm volatile("s_waitcnt lgkmcnt(0)" ::: "memory");
    const int c = lane & 7;
#pragma unroll
    for (int j = 0; j < 4; ++j) { const int n = (lane >> 3) + 8 * j; const float* s = scr + (8 * c) * 33 + n;
        u32x4 o; o.x = pk2(s[0 * 33], s[1 * 33]); o.y = pk2(s[2 * 33], s[3 * 33]); o.z = pk2(s[4 * 33], s[5 * 33]); o.w = pk2(s[6 * 33], s[7 * 33]);
        *(u32x4*)(WT + (size_t)(n0 + n) * ldt + k0 + 8 * c) = o; }
    asm volatile("s_waitcnt lgkmcnt(0)" ::: "memory");
}
__device__ __forceinline__ void prologue(const Args& a, unsigned char* lds, int gw, int NGW, int wid, int lane) {
    unsigned char* ws = a.ws;
    float* scr = (float*)(lds + wid * 16384);
    const float* norm_mix = a.in[2]; const float* norm_mlp = a.in[3];
    constexpr int I_QKV = 16 * 96, I_O = 16 * 32, I_UP = 16 * 128, I_DN = 64 * 32, I_IN = 16 * 64, I_G = 2 * 4;
    constexpr int NITEMS = I_QKV + I_O + 2 * I_UP + 2 * I_DN + I_IN + 16 * I_G + I_O;
    for (int it = gw; it < NITEMS; it += NGW) {
        int r = it;
        if (r < I_QKV) { p0_transpose_item(a.in[4], 1024, 3072, (bf16*)(ws + WS_WQKV), norm_mix, scr, r, lane); continue; } r -= I_QKV;
        if (r < I_O) { p0_transpose_item(a.in[5], 1024, 1024, (bf16*)(ws + WS_WO), nullptr, scr, r, lane); continue; } r -= I_O;
        if (r < I_UP) { p0_transpose_item(a.in[15], 1024, 4096, (bf16*)(ws + WS_WUP0), norm_mlp, scr, r, lane); continue; } r -= I_UP;
        if (r < I_UP) { p0_transpose_item(a.in[15] + (size_t)1024 * 4096, 1024, 4096, (bf16*)(ws + WS_WUP1), norm_mlp + 1024, scr, r, lane); continue; } r -= I_UP;
        if (r < I_DN) { p0_transpose_item(a.in[16], 4096, 1024, (bf16*)(ws + WS_WDN0), nullptr, scr, r, lane, ACT_LD); continue; } r -= I_DN;
        if (r < I_DN) { p0_transpose_item(a.in[16] + (size_t)4096 * 1024, 4096, 1024, (bf16*)(ws + WS_WDN1), nullptr, scr, r, lane, ACT_LD); continue; } r -= I_DN;
        if (r < I_IN) { p0_transpose_item(a.in[6], 1024, 2048, (bf16*)(ws + WS_WIN), norm_mix + 1024, scr, r, lane); continue; } r -= I_IN;
        if (r < 8 * I_G) { const int n = r / I_G; p0_transpose_item(a.in[9] + (size_t)n * 16384, 128, 128, (bf16*)(ws + WS_WRG) + (size_t)n * 16384, nullptr, scr, r % I_G, lane); continue; } r -= 8 * I_G;
        if (r < 8 * I_G) { const int n = r / I_G; p0_transpose_item(a.in[11] + (size_t)n * 16384, 128, 128, (bf16*)(ws + WS_WIG) + (size_t)n * 16384, nullptr, scr, r % I_G, lane); continue; } r -= 8 * I_G;
        p0_transpose_item(a.in[14], 1024, 1024, (bf16*)(ws + WS_WOUT), nullptr, scr, r, lane);
    }
    float* rowss = (float*)(ws + WS_ROWSS); bf16* hb = (bf16*)(ws + WS_HB);
    for (int m0 = 2 * gw; m0 < NREAL + 16; m0 += 2 * NGW) {
        f32x4 v[2][4];
#pragma unroll
        for (int k = 0; k < 2; ++k) { const int m = m0 + k; const float* src = (m < NREAL) ? a.in[0] + (size_t)m * 1024 : a.in[1] + (size_t)(m - NREAL) * 1024;
            const f32x4* xr = (const f32x4*)src + lane;
#pragma unroll
            for (int j = 0; j < 4; ++j) v[k][j] = xr[64 * j]; }
#pragma unroll
        for (int k = 0; k < 2; ++k) { const int m = m0 + k; float s = 0.f;
            unsigned long long* o8 = (unsigned long long*)(hb + (size_t)m * 1024) + lane;
#pragma unroll
            for (int j = 0; j < 4; ++j) { const f32x4 t = v[k][j]; s += (t.x * t.x + t.y * t.y) + (t.z * t.z + t.w * t.w);
                o8[64 * j] = (unsigned long long)pk2(t.x, t.y) | ((unsigned long long)pk2(t.z, t.w) << 32); }
            s = wave_sum(s); if (lane == 0) rowss[m] = s; }
    }
    for (int i = gw * 64 + lane; i < 4 * MALLOC; i += NGW * 64) rowss[MALLOC + i] = 0.f;
    if (gw == 0) ((unsigned*)(ws + WS_PCNT))[lane] = 0u;
    if (gw == 1) { unsigned* sf = (unsigned*)(ws + WS_SFLAG); sf[lane] = 0u; sf[64 + lane] = 0u; sf[128 + lane] = 0u; sf[192 + lane] = 0u; }
}

template <int K, int LD = K> __device__ __forceinline__ f32x4 skinny_tile(const bf16* A, const bf16* Bt, int n0, unsigned char* lds, int wid, int lane) {
    const int r = lane & 15, kq = lane >> 4; constexpr int ks = K >> 3, NS = ks / 32;
    const bf16* ap = A + (size_t)r * LD + wid * ks + 8 * kq; const bf16* bp = Bt + (size_t)(n0 + r) * LD + wid * ks + 8 * kq;
    bf16x8 av[NS], bv[NS];
#pragma unroll
    for (int k = 0; k < NS; ++k) { av[k] = *(const bf16x8*)(ap + 32 * k); bv[k] = *(const bf16x8*)(bp + 32 * k); }
    f32x4 acc = {0.f, 0.f, 0.f, 0.f};
#pragma unroll
    for (int k = 0; k < NS; ++k) acc = __builtin_amdgcn_mfma_f32_16x16x32_bf16(bv[k], av[k], acc, 0, 0, 0);
    f32x4* red = (f32x4*)lds;
    red[wid * 64 + lane] = acc;
    __syncthreads();
    f32x4 sum = {0.f, 0.f, 0.f, 0.f};
    if (wid == 0) {
#pragma unroll
        for (int w = 0; w < 8; ++w) sum += red[w * 64 + lane];
    }
    __syncthreads();
    return sum;
}
enum { SK_QKV = 0, SK_OPROJ = 1, SK_UP = 2, SK_DOWN = 3, SK_WIN = 4 };
template <int MODE> __device__ __forceinline__ void skinny_phase(const Args& a, unsigned char* lds, int G, int wid, int lane) {
    unsigned char* ws = a.ws; float* rowss = (float*)(ws + WS_ROWSS); bf16* hb = (bf16*)(ws + WS_HB); float* hmeta = (float*)(ws + WS_HMETA);
    constexpr int NIT = MODE == SK_QKV ? 192 : MODE == SK_UP ? 256 : 64;
    for (int item = blockIdx.x; item < NIT; item += G) {
        const int m = lane & 15, nq = lane >> 4, MR = MBASE + m;
        if (MODE == SK_QKV) {
            const int n0 = 16 * item; const f32x4 acc = skinny_tile<1024>(hb + (size_t)MBASE * 1024, (const bf16*)(ws + WS_WQKV), n0, lds, wid, lane);
            if (wid == 0) {
                const int n = n0 + 4 * nq, which = n >> 10, c = n & 1023, head = c >> 6, d = c & 63;
                float rs = pg8::rstd_of(rowss[MR]); if (which == 0) rs *= QSCALE;
                const unsigned w0 = pk2(acc[0] * rs, acc[1] * rs), w1 = pk2(acc[2] * rs, acc[3] * rs);
                for (int b = 0; b < 4; ++b) {
                    if (which < 2) { bf16* dst = (bf16*)(ws + (which == 0 ? WS_Q : WS_K)) + ((size_t)((b * 16 + head) * PP + m)) * 64 + d; u32x2 w; w.x = w0; w.y = w1; *(u32x2*)dst = w; }
                    else { bf16* dst = (bf16*)(ws + WS_VT) + ((size_t)((b * 16 + head) * 64 + d)) * PP + m;
                        dst[0] = (bf16)(w0 & 0xffffu); dst[PP] = (bf16)(w0 >> 16); dst[2 * PP] = (bf16)(w1 & 0xffffu); dst[3 * PP] = (bf16)(w1 >> 16); }
                }
            }
        } else if (MODE == SK_OPROJ || MODE == SK_DOWN) {
            const int n0 = 16 * item;
            const f32x4 acc = (MODE == SK_OPROJ) ? skinny_tile<1024>((const bf16*)(ws + WS_O) + (size_t)MBASE * 1024, (const bf16*)(ws + WS_WO), n0, lds, wid, lane)
                                                 : skinny_tile<4096, ACT_LD>((const bf16*)(ws + WS_ACT) + (size_t)MBASE * ACT_LD, (const bf16*)(ws + WS_WDN0), n0, lds, wid, lane);
            if (wid == 0) {
                const int n = n0 + 4 * nq; const float* base = (MODE == SK_OPROJ) ? a.in[1] : hmeta;
                const f32x4 o = *(const f32x4*)(base + m * 1024 + n) + acc;
                *(f32x4*)(hmeta + m * 1024 + n) = o;
                u32x2 w; w.x = pk2(o[0], o[1]); w.y = pk2(o[2], o[3]); *(u32x2*)(hb + (size_t)MR * 1024 + n) = w;
                float ss = (o[0] * o[0] + o[1] * o[1]) + (o[2] * o[2] + o[3] * o[3]); ss += __shfl_xor(ss, 16); ss += __shfl_xor(ss, 32);
                if (nq == 0) atomicAdd(rowss + (MODE == SK_OPROJ ? 1 : 2) * MALLOC + MR, ss);
            }
        } else if (MODE == SK_UP) {
            const int n0 = 16 * item; const f32x4 acc = skinny_tile<1024>(hb + (size_t)MBASE * 1024, (const bf16*)(ws + WS_WUP0), n0, lds, wid, lane);
            if (wid == 0) {
                const int n = n0 + 4 * nq; const float rs = pg8::rstd_of(rowss[1 * MALLOC + MR]);
                float v[4];
#pragma unroll
                for (int e = 0; e < 4; ++e) { const float t = fmaxf(acc[e] * rs, 0.f); v[e] = t * t; }
                u32x2 w; w.x = pk2(v[0], v[1]); w.y = pk2(v[2], v[3]); *(u32x2*)((bf16*)(ws + WS_ACT) + (size_t)MR * ACT_LD + n) = w;
            }
        } else {
            const int n0 = 1024 + 16 * item; const f32x4 acc = skinny_tile<1024>(hb + (size_t)MBASE * 1024, (const bf16*)(ws + WS_WIN), n0, lds, wid, lane);
            if (wid == 0) {
                const int n = n0 + 4 * nq - 1024; const float rs = pg8::rstd_of(rowss[2 * MALLOC + MR]);
                u32x2 w; w.x = pk2(acc[0] * rs, acc[1] * rs); w.y = pk2(acc[2] * rs, acc[3] * rs); *(u32x2*)((bf16*)(ws + WS_REC) + (size_t)MR * 1024 + n) = w;
            }
        }
    }
}

__device__ __forceinline__ void attn_half(const bf16x8 (&kf)[4], const bf16x8 (&vf)[2][2], const bf16x8 (&qf)[4], float& Prun, f32x16& o0, f32x16& o1, int key0, int qp, int hi) {
    f32x16 s;
#pragma unroll
    for (int r = 0; r < 16; ++r) s[r] = 0.f;
#pragma unroll
    for (int dc = 0; dc < 4; ++dc) s = __builtin_amdgcn_mfma_f32_32x32x16_bf16(kf[dc], qf[dc], s, 0, 0, 0);
    float kap[16];
#pragma unroll
    for (int r = 0; r < 16; ++r) {
        const int key = key0 + 16 * (r >> 3) + 8 * hi + (r & 7);
        const float kk = __builtin_amdgcn_rcpf(1.0f + __builtin_amdgcn_exp2f(s[r]));
        kap[r] = ((key < qp) && (key >= 0)) ? kk : 1.f;
    }
    float cc[16]; float t1 = 1.f, t0 = 1.f;
#pragma unroll
    for (int r = 15; r >= 8; --r) { cc[r] = t1; t1 *= kap[r]; }
#pragma unroll
    for (int r = 7; r >= 0; --r) { cc[r] = t0; t0 *= kap[r]; }
    const float G1 = t1, G0 = t0;
    const float G0o = __shfl_xor(G0, 32), G1o = __shfl_xor(G1, 32);
    const float pre1 = hi ? Prun : Prun * G1o;
    const float pre0 = hi ? Prun * G1 * G1o : Prun * G1o * G1 * G0o;
    Prun = Prun * G1 * G1o * G0 * G0o;
    float w[16];
#pragma unroll
    for (int r = 15; r >= 9; --r) w[r] = pre1 * (cc[r] - cc[r - 1]);
    w[8] = pre1 * (cc[8] - G1);
#pragma unroll
    for (int r = 7; r >= 1; --r) w[r] = pre0 * (cc[r] - cc[r - 1]);
    w[0] = pre0 * (cc[0] - G0);
    u32x4 p0, p1;
    p0.x = pg8::cvt_pk_bf16(w[0], w[1]); p0.y = pg8::cvt_pk_bf16(w[2], w[3]); p0.z = pg8::cvt_pk_bf16(w[4], w[5]); p0.w = pg8::cvt_pk_bf16(w[6], w[7]);
    p1.x = pg8::cvt_pk_bf16(w[8], w[9]); p1.y = pg8::cvt_pk_bf16(w[10], w[11]); p1.z = pg8::cvt_pk_bf16(w[12], w[13]); p1.w = pg8::cvt_pk_bf16(w[14], w[15]);
    const bf16x8 pf0 = __builtin_bit_cast(bf16x8, p0), pf1 = __builtin_bit_cast(bf16x8, p1);
    o0 = __builtin_amdgcn_mfma_f32_32x32x16_bf16(vf[0][0], pf0, o0, 0, 0, 0);
    o0 = __builtin_amdgcn_mfma_f32_32x32x16_bf16(vf[0][1], pf1, o0, 0, 0, 0);
    o1 = __builtin_amdgcn_mfma_f32_32x32x16_bf16(vf[1][0], pf0, o1, 0, 0, 0);
    o1 = __builtin_amdgcn_mfma_f32_32x32x16_bf16(vf[1][1], pf1, o1, 0, 0, 0);
}
__device__ __forceinline__ void attn_store(bf16* O, int row, int h, int hi, const f32x16& o0, const f32x16& o1) {
    bf16* op = O + (size_t)row * 1024 + h * 64 + 4 * hi;
#pragma unroll
    for (int g4 = 0; g4 < 4; ++g4) {
        u32x2 wa; wa.x = pg8::cvt_pk_bf16(o0[4 * g4], o0[4 * g4 + 1]); wa.y = pg8::cvt_pk_bf16(o0[4 * g4 + 2], o0[4 * g4 + 3]); *(u32x2*)(op + 8 * g4) = wa;
        u32x2 wb; wb.x = pg8::cvt_pk_bf16(o1[4 * g4], o1[4 * g4 + 1]); wb.y = pg8::cvt_pk_bf16(o1[4 * g4 + 2], o1[4 * g4 + 3]); *(u32x2*)(op + 32 + 8 * g4) = wb;
    }
}
__device__ __forceinline__ void attn_phase(const bf16* Q, const bf16* Kb, const bf16* Vt, bf16* O, int gw, int NGW, int lane) {
    const int q = lane & 31, hi = lane >> 5;
    const int pi = (q & 0x13) | ((q & 4) << 1) | ((q & 8) >> 1);
    for (int item = gw; item < 4096 + 16; item += NGW) {
        const bool metaq = item >= 4096;
        const int bh = metaq ? item - 4096 : (item & 63), j2 = metaq ? -1 : (item >> 6), b = bh >> 4, h = bh & 15;
        const size_t base = (size_t)bh * PP;
        const int q0 = 16 + 64 * j2;
        const int qpA = metaq ? q : q0 + q, qpB = metaq ? -1 : q0 + 32 + q;
        const bool validA = metaq ? (q < 16) : true, validB = !metaq;
        bf16x8 qfA[4], qfB[4];
#pragma unroll
        for (int dc = 0; dc < 4; ++dc) { qfA[dc] = *(const bf16x8*)(Q + (base + qpA) * 64 + 16 * dc + 8 * hi); qfB[dc] = *(const bf16x8*)(Q + (base + (qpB < 0 ? 0 : qpB)) * 64 + 16 * dc + 8 * hi); }
        f32x16 oA0, oA1, oB0, oB1;
#pragma unroll
        for (int r = 0; r < 16; ++r) { oA0[r] = 0.f; oA1[r] = 0.f; oB0[r] = 0.f; oB1[r] = 0.f; }
        float PrunA = validA ? 1.0f : 0.0f, PrunB = validB ? 1.0f : 0.0f;
        const int nunits = metaq ? 1 : 2 * j2 + 3;
        const int kfirst = metaq ? -16 : q0 + 32;
        bf16x8 kfn[4], vfn[2][2];
        {
            const int kk = kfirst + pi; const bf16* kp = Kb + (base + (kk < 0 ? 0 : kk)) * 64 + 8 * hi;
#pragma unroll
            for (int dc = 0; dc < 4; ++dc) kfn[dc] = *(const bf16x8*)(kp + 16 * dc);
#pragma unroll
            for (int db = 0; db < 2; ++db)
#pragma unroll
                for (int c = 0; c < 2; ++c) { const int col = kfirst + 16 * c + 8 * hi; vfn[db][c] = *(const bf16x8*)(Vt + ((size_t)(bh * 64 + db * 32 + q)) * PP + (col < 0 ? 0 : col)); }
        }
        for (int u = 0; u < nunits; ++u) {
            const int key0 = kfirst - 32 * u;
            bf16x8 kf[4], vf[2][2];
#pragma unroll
            for (int dc = 0; dc < 4; ++dc) kf[dc] = kfn[dc];
#pragma unroll
            for (int db = 0; db < 2; ++db)
#pragma unroll
                for (int c = 0; c < 2; ++c) vf[db][c] = vfn[db][c];
            if (u + 1 < nunits) {
                const int k1 = key0 - 32; const int kk = k1 + pi; const bf16* kp = Kb + (base + (kk < 0 ? 0 : kk)) * 64 + 8 * hi;
#pragma unroll
                for (int dc = 0; dc < 4; ++dc) kfn[dc] = *(const bf16x8*)(kp + 16 * dc);
#pragma unroll
                for (int db = 0; db < 2; ++db)
#pragma unroll
                    for (int c = 0; c < 2; ++c) { const int col = k1 + 16 * c + 8 * hi; vfn[db][c] = *(const bf16x8*)(Vt + ((size_t)(bh * 64 + db * 32 + q)) * PP + (col < 0 ? 0 : col)); }
            }
            attn_half(kf, vf, qfA, PrunA, oA0, oA1, key0, qpA, hi);
            attn_half(kf, vf, qfB, PrunB, oB0, oB1, key0, qpB, hi);
            if (__all((PrunA < 1e-37f) && (PrunB < 1e-37f))) break;
        }
        if (validA) attn_store(O, metaq ? MBASE + q : b * 4096 + qpA - 16, h, hi, oA0, oA1);
        if (validB) attn_store(O, b * 4096 + qpB - 16, h, hi, oB0, oB1);
    }
}
__device__ __forceinline__ float sigmoidf_(float x) { return __builtin_amdgcn_rcpf(1.0f + __builtin_amdgcn_exp2f(-1.4426950408889634f * x)); }
#define LDS_BAR() asm volatile("s_waitcnt lgkmcnt(0)\n\ts_barrier" ::: "memory")
__device__ __forceinline__ void scanfix_phase(const Args& a, unsigned char* lds, int G, int tid, int wid, int lane) {
    unsigned char* ws = a.ws;
    const bf16* rec = (const bf16*)(ws + WS_REC); bf16* HL = (bf16*)(ws + WS_HL); bf16* PC = (bf16*)(ws + WS_PC);
    float* carA = (float*)(ws + WS_CARA); float* carB = (float*)(ws + WS_CARB); float* hmend = (float*)(ws + WS_HMEND);
    const float* conv_w = a.in[7]; const float* conv_b = a.in[8]; const float* b_rg = a.in[10]; const float* b_ig = a.in[12]; const float* lam = a.in[13];
    float* u32f = (float*)lds;
    bf16* ubf = (bf16*)(lds + 33792);
    float* segs = (float*)(lds + 33792 + 17408);
    const int g = wid & 3, th = wid >> 2, q = lane & 31, hi = lane >> 5;
    const int tau = (q & 3) | (((q >> 3) & 3) << 2) | (((q >> 2) & 1) << 4);
    int cur_n = -1; float brg = 0.f, big = 0.f, cch = 0.f;
    bf16* wl = (bf16*)(lds + 33792 + 17408 + 4096 + 2560);
    float* cwl = (float*)(lds + 33792 + 17408 + 4096);
    const int ti = tid >> 3, cg8 = tid & 7;
    bf16x8 rn[8];
#define LOAD_REC(idq) do { const bool meta_ = (idq) >= 2048; const int n_ = (idq) & 7; int b_ = 0, c_ = 0; if (!meta_) { const int bc_ = (idq) >> 3; b_ = bc_ >> 6; c_ = bc_ & 63; } \
        _Pragma("unroll") for (int jt = 0; jt < 4; ++jt) { const int tt = (meta_ ? ti : 64 * c_ + ti) - 3 + jt; int row; if (meta_) row = (tt >= 0) ? MBASE + tt : -1; else row = (tt >= 0) ? b_ * 4096 + tt : MBASE + 16 + tt; \
            if (row >= 0) { rn[2 * jt] = *(const bf16x8*)(rec + (size_t)row * 1024 + 128 * n_ + 16 * cg8); rn[2 * jt + 1] = *(const bf16x8*)(rec + (size_t)row * 1024 + 128 * n_ + 16 * cg8 + 8); } \
            else { rn[2 * jt] = (bf16x8){0, 0, 0, 0, 0, 0, 0, 0}; rn[2 * jt + 1] = (bf16x8){0, 0, 0, 0, 0, 0, 0, 0}; } } } while (0)
    const int wn = blockIdx.x & 7, sg = (blockIdx.x >> 3) & 7, wb = blockIdx.x >> 6;
    const int NIT = (sg == 0) ? 9 : 8;
#define SID(k_) ((sg == 0) ? ((k_) == 0 ? 2048 + wn : ((((wb * 64 + 8 * sg + (k_) - 1)) << 3) | wn)) : ((((wb * 64 + 8 * sg + (k_))) << 3) | wn))
    float* carr = (float*)(lds + 127488);
    float* hin_l = (float*)(lds + 127488 + 2048);
    if (tid < 128) { carr[2 * tid] = 1.f; carr[2 * tid + 1] = 0.f; }
    LOAD_REC(SID(0));
    for (int kk = 0; kk < NIT; ++kk) {
        const int id = SID(kk);
        const bool meta = id >= 2048; const int n = id & 7; int b = 0, c = 0; if (!meta) { const int bc = id >> 3; b = bc >> 6; c = bc & 63; }
        const int ch = 128 * n + 32 * g + q;
        if (n != cur_n) {
            for (int i = tid; i < 2 * 128 * 16; i += NTHREADS) { const int gsel = i >> 11, orow = (i >> 4) & 127, pc16 = i & 15;
                const bf16* src = (const bf16*)(ws + (gsel ? WS_WIG : WS_WRG)) + ((size_t)(n * 128 + orow)) * 128 + 8 * pc16;
                *(u32x4*)(wl + (gsel * 128 + orow) * 136 + 8 * pc16) = *(const u32x4*)src; }
            brg = b_rg[ch]; big = b_ig[ch]; cch = -8.0f * 1.4426950408889634f * log1pf(expf(-lam[ch])); cur_n = n;
            for (int i = tid; i < 640; i += NTHREADS) cwl[i] = (i < 512) ? conv_w[(i >> 7) * 1024 + 128 * n + (i & 127)] : conv_b[128 * n + (i - 512)];
            __syncthreads();
        }
        {
            float u[16];
#pragma unroll
            for (int e4 = 0; e4 < 4; ++e4) { const f32x4 bb = *(const f32x4*)(cwl + 512 + 16 * cg8 + 4 * e4); u[4 * e4] = bb[0]; u[4 * e4 + 1] = bb[1]; u[4 * e4 + 2] = bb[2]; u[4 * e4 + 3] = bb[3]; }
#pragma unroll
            for (int jt = 0; jt < 4; ++jt) {
                const bf16x8 r0 = rn[2 * jt], r1 = rn[2 * jt + 1];
#pragma unroll
                for (int e4 = 0; e4 < 4; ++e4) { const f32x4 wv = *(const f32x4*)(cwl + jt * 128 + 16 * cg8 + 4 * e4);
#pragma unroll
                    for (int e = 0; e < 4; ++e) { const int idx = 4 * e4 + e; const float rv = bf2f((unsigned short)(idx < 8 ? r0[idx] : r1[idx - 8])); u[idx] += rv * wv[e]; } }
            }
            if (kk + 1 < NIT) LOAD_REC(SID(kk + 1));
#pragma unroll
            for (int e4 = 0; e4 < 4; ++e4) { f32x4 v = {u[4 * e4], u[4 * e4 + 1], u[4 * e4 + 2], u[4 * e4 + 3]}; *(f32x4*)(u32f + ti * 132 + 16 * cg8 + 4 * e4) = v; }
            u32x4 w0, w1; w0.x = pk2(u[0], u[1]); w0.y = pk2(u[2], u[3]); w0.z = pk2(u[4], u[5]); w0.w = pk2(u[6], u[7]);
            w1.x = pk2(u[8], u[9]); w1.y = pk2(u[10], u[11]); w1.z = pk2(u[12], u[13]); w1.w = pk2(u[14], u[15]);
            *(u32x4*)(ubf + ti * 136 + 16 * cg8) = w0; *(u32x4*)(ubf + ti * 136 + 16 * cg8 + 8) = w1;
        }
        LDS_BAR();
        f32x16 Dr, Di;
#pragma unroll
        for (int r = 0; r < 16; ++r) { Dr[r] = 0.f; Di[r] = 0.f; }
#pragma unroll
        for (int ks = 0; ks < 8; ++ks) { const bf16x8 af = *(const bf16x8*)(ubf + (32 * th + tau) * 136 + 16 * ks + 8 * hi);
            const bf16x8 wrv = *(const bf16x8*)(wl + (32 * g + q) * 136 + 16 * ks + 8 * hi), wiv = *(const bf16x8*)(wl + (128 + 32 * g + q) * 136 + 16 * ks + 8 * hi);
            Dr = __builtin_amdgcn_mfma_f32_32x32x16_bf16(af, wrv, Dr, 0, 0, 0); Di = __builtin_amdgcn_mfma_f32_32x32x16_bf16(af, wiv, Di, 0, 0, 0); }
        float hl[16], pc[16]; float hcur = 0.f, P = 1.f;
#pragma unroll
        for (int r = 0; r < 16; ++r) {
            const int tok = 32 * th + 16 * hi + r; const float uval = u32f[tok * 132 + 32 * g + q];
            const float rr = sigmoidf_(Dr[r] + brg), ii = sigmoidf_(Di[r] + big);
            float av = __builtin_amdgcn_exp2f(cch * rr); float bt = __builtin_amdgcn_sqrtf((1.0f - av) * (1.0f + av)) * ii * uval;
            if (meta && tok >= 16) { av = 1.f; bt = 0.f; }
            hcur = av * hcur + bt; P *= av; hl[r] = hcur; pc[r] = P;
        }
        const int seg = 2 * th + hi;
        segs[(seg * 128 + 32 * g + q) * 2] = P; segs[(seg * 128 + 32 * g + q) * 2 + 1] = hcur;
        LDS_BAR();
        const float* cin = carr + (kk & 1) * 256;
        float hin = cin[2 * (32 * g + q) + 1], Pin = cin[2 * (32 * g + q)];
#pragma unroll
        for (int s = 0; s < 3; ++s) if (s < seg) { const float A_ = segs[(s * 128 + 32 * g + q) * 2], B_ = segs[(s * 128 + 32 * g + q) * 2 + 1]; hin = A_ * hin + B_; Pin *= A_; }
#pragma unroll
        for (int r = 0; r < 16; ++r) { hl[r] += pc[r] * hin; pc[r] *= Pin; }
        if (!meta) {
            bf16* hlt = (bf16*)lds; bf16* pct = (bf16*)(lds + 17408);
#pragma unroll
            for (int r = 0; r < 16; ++r) { const int o_ = (32 * th + 16 * hi + r) * 136 + 32 * g + q; hlt[o_] = (bf16)f2bf(hl[r]); pct[o_] = (bf16)f2bf(pc[r]); }
            LDS_BAR();
#pragma unroll
            for (int k = 0; k < 2; ++k) { const int p_ = tid + NTHREADS * k, row = p_ >> 4, cpos = (p_ & 15) * 8; const size_t go = ((size_t)b * 4096 + 64 * c + row) * 1024 + 128 * n + cpos;
                *(u32x4*)(HL + go) = *(const u32x4*)(hlt + row * 136 + cpos); *(u32x4*)(PC + go) = *(const u32x4*)(pct + row * 136 + cpos); }
        }
        if (seg == 3) { float* cout = carr + ((kk + 1) & 1) * 256; cout[2 * (32 * g + q)] = pc[15]; cout[2 * (32 * g + q) + 1] = hl[15]; }
        LDS_BAR();
    }
#undef LOAD_REC
#undef SID
    float* agg = (float*)(ws + WS_CARA);
    unsigned* sflag = (unsigned*)(ws + WS_SFLAG);
    const int strm = wb * 8 + wn;
    {
        const float* cfin = carr + (NIT & 1) * 256;
        if (tid < 256) __hip_atomic_store(agg + ((size_t)(strm * 8 + sg)) * 256 + tid, cfin[tid], __ATOMIC_RELAXED, __HIP_MEMORY_SCOPE_AGENT);
    }
    asm volatile("s_waitcnt vmcnt(0)" ::: "memory");
    __syncthreads();
    if (tid == 0) __hip_atomic_store(sflag + strm * 8 + sg, 1u, __ATOMIC_RELAXED, __HIP_MEMORY_SCOPE_AGENT);
    if (tid < sg) { unsigned spins = 0; while (__hip_atomic_load(sflag + strm * 8 + tid, __ATOMIC_RELAXED, __HIP_MEMORY_SCOPE_AGENT) != 1u) { __builtin_amdgcn_s_sleep(2); if (++spins > (1u << 22)) break; } }
    __syncthreads();
    if (tid < 128) {
        float Av[7], Bv[7];
#pragma unroll
        for (int t = 0; t < 7; ++t) { Av[t] = 1.f; Bv[t] = 0.f; if (t < sg) { Av[t] = __hip_atomic_load(agg + ((size_t)(strm * 8 + t)) * 256 + 2 * tid, __ATOMIC_RELAXED, __HIP_MEMORY_SCOPE_AGENT);
            Bv[t] = __hip_atomic_load(agg + ((size_t)(strm * 8 + t)) * 256 + 2 * tid + 1, __ATOMIC_RELAXED, __HIP_MEMORY_SCOPE_AGENT); } }
        float h = 0.f;
#pragma unroll
        for (int t = 0; t < 7; ++t) if (t < sg) h = Av[t] * h + Bv[t];
        hin_l[tid] = h;
    }
    __syncthreads();
    {
        const bf16* GT = (const bf16*)(ws + WS_GATE); bf16* Y = (bf16*)(ws + WS_Y);
        for (int cc0 = 0; cc0 < 8; cc0 += 2) {
            u32x4 hv[2][2], pv[2][2], gv[2][2];
#pragma unroll
            for (int j = 0; j < 2; ++j)
#pragma unroll
                for (int k = 0; k < 2; ++k) { const int p_ = tid + NTHREADS * k, row = p_ >> 4, cpos = (p_ & 15) * 8;
                    const size_t go = ((size_t)wb * 4096 + 64 * (8 * sg + cc0 + j) + row) * 1024 + 128 * wn + cpos;
                    hv[j][k] = *(const u32x4*)(HL + go); pv[j][k] = *(const u32x4*)(PC + go); gv[j][k] = *(const u32x4*)(GT + go); }
#pragma unroll
            for (int j = 0; j < 2; ++j)
#pragma unroll
                for (int k = 0; k < 2; ++k) { const int p_ = tid + NTHREADS * k, row = p_ >> 4, cpos = (p_ & 15) * 8;
                    const size_t go = ((size_t)wb * 4096 + 64 * (8 * sg + cc0 + j) + row) * 1024 + 128 * wn + cpos;
                    u32x4 yo;
#pragma unroll
                    for (int e = 0; e < 4; ++e) { const float h0 = hin_l[cpos + 2 * e], h1 = hin_l[cpos + 2 * e + 1];
                        yo[e] = pk2((pg8::bflo(hv[j][k][e]) + pg8::bflo(pv[j][k][e]) * h0) * pg8::bflo(gv[j][k][e]), (pg8::bfhi(hv[j][k][e]) + pg8::bfhi(pv[j][k][e]) * h1) * pg8::bfhi(gv[j][k][e])); }
                    *(u32x4*)(Y + go) = yo; }
        }
    }
}
__device__ __forceinline__ void final_norm(const Args& a, int gw, int NGW, int lane) {
    const float* rowss4 = (const float*)(a.ws + WS_ROWSS) + 4 * MALLOC; const float* gfin = a.in[17]; const bf16* hb = (const bf16*)(a.ws + WS_HB);
    const f32x4 g0 = ((const f32x4*)gfin)[2 * lane], g1 = ((const f32x4*)gfin)[2 * lane + 1], g2 = ((const f32x4*)gfin)[128 + 2 * lane], g3 = ((const f32x4*)gfin)[128 + 2 * lane + 1];
    for (int m = gw; m < NREAL; m += NGW) {
        const float rs = pg8::rstd_of(rowss4[m]); const u32x4* hp = (const u32x4*)(hb + (size_t)m * 1024) + lane; f32x4* p = (f32x4*)(a.out + (size_t)m * 1024);
        const u32x4 v0 = hp[0], v1 = hp[64];
        f32x4 o;
        o = (f32x4){pg8::bflo(v0.x), pg8::bfhi(v0.x), pg8::bflo(v0.y), pg8::bfhi(v0.y)}; p[2 * lane] = o * rs * g0;
        o = (f32x4){pg8::bflo(v0.z), pg8::bfhi(v0.z), pg8::bflo(v0.w), pg8::bfhi(v0.w)}; p[2 * lane + 1] = o * rs * g1;
        o = (f32x4){pg8::bflo(v1.x), pg8::bfhi(v1.x), pg8::bflo(v1.y), pg8::bfhi(v1.y)}; p[128 + 2 * lane] = o * rs * g2;
        o = (f32x4){pg8::bflo(v1.z), pg8::bfhi(v1.z), pg8::bflo(v1.w), pg8::bfhi(v1.w)}; p[128 + 2 * lane + 1] = o * rs * g3;
    }
}

#define XB_TMO      128
#define XB_XCNT(j)  (256  + 64 * (j))
#define XB_XSUB(j)  (1280 + 64 * (j))
#define XB_XGEN(j)  (2304 + 64 * (j))
#define XB_TOP      3328
#define XB_TOPGEN   3392
#define XCD_BAR_WORDS 3456
#define XB_SPIN_CAP (1u << 18)

__device__ __forceinline__ unsigned xb_ld(unsigned* p)              { return __hip_atomic_load(p, __ATOMIC_RELAXED, __HIP_MEMORY_SCOPE_AGENT); }
__device__ __forceinline__ unsigned xb_add(unsigned* p, unsigned v) { return __hip_atomic_fetch_add(p, v, __ATOMIC_RELAXED, __HIP_MEMORY_SCOPE_AGENT); }
__device__ __forceinline__ unsigned xb_xcc_id() { return (unsigned)__builtin_amdgcn_s_getreg((3 << 11) | 20) & 0xFu; }
#define XB_SPIN(cond, bar) do { unsigned _sp = 0; while (cond) { __builtin_amdgcn_s_sleep(1); \
    if ((++_sp & 255u) == 0u) { if (xb_ld(&(bar)[XB_TMO])) break; if (_sp > XB_SPIN_CAP) { atomicAdd(&(bar)[XB_TMO], 1u); break; } } } } while (0)

struct XcdBarrier {
    unsigned* bar; unsigned x;
    volatile LAS unsigned* st;
};

__device__ __forceinline__ XcdBarrier xcd_barrier_post(unsigned* bar, volatile LAS unsigned* st) {
    XcdBarrier b; b.bar = bar; b.x = xb_xcc_id(); b.st = st;
    if (threadIdx.x == 0) (void)xb_add(&bar[XB_XCNT(b.x)], 1u);
    return b;
}
__device__ __forceinline__ void xcd_barrier_complete(unsigned* bar, unsigned x, unsigned& nloc, unsigned& nx) {
    const unsigned G = gridDim.x * gridDim.y * gridDim.z;
    unsigned sum, cnt, mine, sp = 0u;
    for (;;) {
        sum = 0u; cnt = 0u; mine = 0u;
#pragma unroll
        for (unsigned j = 0; j < 16; ++j) { const unsigned c = xb_ld(&bar[XB_XCNT(j)]); sum += c; cnt += (c > 0u) ? 1u : 0u; mine = (j == x) ? c : mine; }
        if (sum == G) break;
        __builtin_amdgcn_s_sleep(1);
        if ((++sp & 255u) == 0u) { if (xb_ld(&bar[XB_TMO])) break; if (sp > XB_SPIN_CAP) { atomicAdd(&bar[XB_TMO], 1u); break; } }
    }
    nloc = mine > 0u ? mine : 1u; nx = cnt > 0u ? cnt : 1u;
}

__device__ __forceinline__ void xcd_barrier(const XcdBarrier& b) {
    asm volatile("s_waitcnt vmcnt(0)" ::: "memory");
    __syncthreads();
    if (threadIdx.x == 0) {
        unsigned* bar = b.bar;
        __builtin_amdgcn_s_waitcnt(0);
        unsigned nloc = b.st[0], nx = b.st[1];
        if (nloc == 0u) { xcd_barrier_complete(bar, b.x, nloc, nx); b.st[0] = nloc; b.st[1] = nx; }
        const unsigned old = xb_add(&bar[XB_XSUB(b.x)], 1u);
        const unsigned gen = old / nloc;
        if (old + 1u == (gen + 1u) * nloc) {
            __builtin_amdgcn_fence(__ATOMIC_RELEASE, "agent");
            asm volatile("s_waitcnt vmcnt(0)" ::: "memory");
            const unsigned og = xb_add(&bar[XB_TOP], 1u);
            const unsigned tg = og / nx;
            if (og + 1u == (tg + 1u) * nx) xb_add(&bar[XB_TOPGEN], 1u);
            else XB_SPIN(xb_ld(&bar[XB_TOPGEN]) == tg, bar);
            __builtin_amdgcn_fence(__ATOMIC_ACQUIRE, "agent");
            xb_add(&bar[XB_XGEN(b.x)], 1u);
            asm volatile("s_waitcnt vmcnt(0)" ::: "memory");
        } else {
            XB_SPIN(xb_ld(&bar[XB_XGEN(b.x)]) == gen, bar);
            __builtin_amdgcn_fence(__ATOMIC_ACQUIRE, "agent");
            asm volatile("s_waitcnt vmcnt(0)" ::: "memory");
        }
    }
    __syncthreads();
}

__global__ void __launch_bounds__(NTHREADS, 2) fwd_kernel(Args args) {
    extern __shared__ __attribute__((aligned(16))) unsigned char lds[];
    cg::grid_group grid = cg::this_grid();
    const int tid = threadIdx.x, lane = tid & 63, wid = __builtin_amdgcn_readfirstlane(tid >> 6);
    const int G = gridDim.x, gw = blockIdx.x * NWAVES + wid, NGW = G * NWAVES;
    unsigned char* ws = args.ws; float* rowss = (float*)(ws + WS_ROWSS); bf16* hb = (bf16*)(ws + WS_HB);
    const int lo = args.ph_lo, hi = args.ph_hi;
#define IN(k) (lo <= (k) && (k) < hi)
#define SEAM(k) do { if (IN(k) && IN((k) + 1)) xcd_barrier(xb); } while (0)
    unsigned* barw = (unsigned*)(ws + WS_BAR); volatile LAS unsigned* st = (volatile LAS unsigned*)((LAS unsigned char*)lds + 131072 + 32);
    if (tid < 2) st[tid] = 0u;
    __syncthreads();
    if (lo < 0) grid.sync();
    XcdBarrier xb = xcd_barrier_post(barw, st);
    PG8_LAS unsigned char* ldsp = (PG8_LAS unsigned char*)lds;
    PG8_LAS float* rstl = (PG8_LAS float*)((PG8_LAS unsigned char*)lds + 131072 + 1024);
#define FILL_RST(ROWSS) int nrst_ = 0; { pg8::Unit uu_; while (nrst_ < 12 && S.next(nrst_, uu_)) { if (tid < 256) rstl[nrst_ * 256 + tid] = pg8::rstd_of((ROWSS)[uu_.pm * 256 + tid]); ++nrst_; } } __syncthreads()
    if (IN(0)) { prologue(args, lds, gw, NGW, wid, lane); } SEAM(0);
    if (IN(1)) {
        skinny_phase<SK_QKV>(args, lds, G, wid, lane);
        pg8::Gemm g{hb, (const bf16*)(ws + WS_WQKV), NREAL, 3072, 1024, 1024, 1024}; pg8::StaticOrder S; S.init(NREAL, 3072, G, (int)blockIdx.x);
        FILL_RST(rowss);
        pg8::EpiQKV E{(bf16*)(ws + WS_Q), (bf16*)(ws + WS_K), (bf16*)(ws + WS_VT), rowss, QSCALE, rstl, nrst_, (PG8_LAS unsigned char*)lds + 131072 + 1024 + 12288};
        pg8::gemm_phase<pg8::EpiQKV, pg8::StaticOrder, true, true>(ldsp, g, S, E);
    } SEAM(1);
    if (IN(2)) { attn_phase((const bf16*)(ws + WS_Q), (const bf16*)(ws + WS_K), (const bf16*)(ws + WS_VT), (bf16*)(ws + WS_O), gw, NGW, lane); } SEAM(2);
    if (IN(3)) {
        skinny_phase<SK_OPROJ>(args, lds, G, wid, lane);
        pg8::Gemm g{(const bf16*)(ws + WS_O), (const bf16*)(ws + WS_WO), NREAL, 1024, 1024, 1024, 1024}; pg8::StaticOrder S; S.init(NREAL, 1024, G, (int)blockIdx.x);
        pg8::EpiResid E{hb, rowss + 1 * MALLOC};
        pg8::gemm_phase<pg8::EpiResid, pg8::StaticOrder, true, true>(ldsp, g, S, E);
    } SEAM(3);
    if (IN(4)) {
        skinny_phase<SK_UP>(args, lds, G, wid, lane);
        pg8::Gemm g{hb, (const bf16*)(ws + WS_WUP0), NREAL, 4096, 1024, 1024, 1024}; pg8::StaticOrder S; S.init(NREAL, 4096, G, (int)blockIdx.x);
        FILL_RST(rowss + 1 * MALLOC);
        pg8::EpiUp E{(bf16*)(ws + WS_ACT), rowss + 1 * MALLOC, rstl, nrst_};
        pg8::gemm_phase<pg8::EpiUp, pg8::StaticOrder, true, true>(ldsp, g, S, E);
    }
    SEAM(4);
    if (IN(5)) {
        skinny_phase<SK_DOWN>(args, lds, G, wid, lane);
        pg8::Gemm g{(const bf16*)(ws + WS_ACT), (const bf16*)(ws + WS_WDN0), NREAL, 1024, 4096, ACT_LD, ACT_LD}; pg8::StaticOrder S; S.init(NREAL, 1024, G, (int)blockIdx.x);
        pg8::EpiResid E{hb, rowss + 2 * MALLOC};
        pg8::gemm_phase<pg8::EpiResid, pg8::StaticOrder, true, true>(ldsp, g, S, E);
    }
    SEAM(5);
    if (IN(6)) {
        skinny_phase<SK_WIN>(args, lds, G, wid, lane);
        pg8::Gemm g{hb, (const bf16*)(ws + WS_WIN), NREAL, 2048, 1024, 1024, 1024}; pg8::StaticOrder S; S.init(NREAL, 2048, G, (int)blockIdx.x);
        FILL_RST(rowss + 2 * MALLOC);
        pg8::EpiWin E{(bf16*)(ws + WS_GATE), (bf16*)(ws + WS_REC), rowss + 2 * MALLOC, rstl, nrst_};
        pg8::gemm_phase<pg8::EpiWin, pg8::StaticOrder, true, true>(ldsp, g, S, E);
    } SEAM(6);
    if (IN(7)) { scanfix_phase(args, lds, G, tid, wid, lane); }
    SEAM(8);
    if (IN(9)) {
        pg8::Gemm g{(const bf16*)(ws + WS_Y), (const bf16*)(ws + WS_WOUT), NREAL, 1024, 1024, 1024, 1024}; pg8::StaticOrder S; S.init(NREAL, 1024, G, (int)blockIdx.x);
        pg8::EpiResid E{hb, rowss + 3 * MALLOC};
        pg8::gemm_phase<pg8::EpiResid, pg8::StaticOrder, true, true>(ldsp, g, S, E);
    } SEAM(9);
    if (IN(10)) {
        pg8::Gemm g{hb, (const bf16*)(ws + WS_WUP1), NREAL, 4096, 1024, 1024, 1024}; pg8::StaticOrder S; S.init(NREAL, 4096, G, (int)blockIdx.x);
        FILL_RST(rowss + 3 * MALLOC);
        pg8::EpiUp E{(bf16*)(ws + WS_ACT), rowss + 3 * MALLOC, rstl, nrst_};
        pg8::gemm_phase<pg8::EpiUp, pg8::StaticOrder, true, true>(ldsp, g, S, E);
    } SEAM(10);
    if (IN(11)) {
        pg8::Gemm g{(const bf16*)(ws + WS_ACT), (const bf16*)(ws + WS_WDN1), NREAL, 1024, 4096, ACT_LD, ACT_LD}; pg8::StaticOrder S; S.init(NREAL, 1024, G, (int)blockIdx.x);
        if (G == 256) {
            pg8::EpiFinal E{hb, rowss + 4 * MALLOC, args.out, args.in[17], (unsigned*)(ws + WS_PCNT)};
            pg8::gemm_phase<pg8::EpiFinal, pg8::StaticOrder, false, true>(ldsp, g, S, E);
        } else {
            pg8::EpiResid E{hb, rowss + 4 * MALLOC};
            pg8::gemm_phase<pg8::EpiResid, pg8::StaticOrder, true, true>(ldsp, g, S, E);
        }
    }
    if (G != 256) { SEAM(11); if (IN(12)) { final_norm(args, gw, NGW, lane); } }
#undef IN
#undef SEAM
}

#ifndef N_LAUNCH_MODE
#define N_LAUNCH_MODE 1
#endif
extern "C" void kernel_launch(void* const* d_in, const int* in_sizes, int n_in, void* d_out, int out_size, void* d_ws, size_t ws_size, hipStream_t stream) {
    static int grid = 0;
    if (grid == 0) {
        if (n_in != 18 || out_size != NREAL * DM || ws_size < WS_END) { fprintf(stderr, "kernel_launch: unexpected shapes (n_in %d out %d ws %zu)\n", n_in, out_size, ws_size); grid = -1; return; }
        int dev = 0, cus = 0, per_cu = 0;
        hipGetDevice(&dev); hipDeviceGetAttribute(&cus, hipDeviceAttributeMultiprocessorCount, dev);
        if (hipFuncSetAttribute((const void*)fwd_kernel, hipFuncAttributeMaxDynamicSharedMemorySize, LDS_BYTES) != hipSuccess) { fprintf(stderr, "kernel_launch: hipFuncSetAttribute failed\n"); grid = -1; return; }
        if (hipOccupancyMaxActiveBlocksPerMultiprocessor(&per_cu, (const void*)fwd_kernel, NTHREADS, LDS_BYTES) != hipSuccess || per_cu < 1) { fprintf(stderr, "kernel_launch: occupancy query gave %d\n", per_cu); per_cu = 1; }
        (void)hipGetLastError();
        grid = cus;
        if (grid != 256) { fprintf(stderr, "kernel_launch: %d CUs: the fused scan phase is laid out for 256 workgroups; nothing launched\n", grid); grid = -1; return; }
        if (grid < 96) { fprintf(stderr, "kernel_launch: %d CUs: the per-workgroup rstd table holds 12 units; nothing launched\n", grid); grid = -1; return; }
        fprintf(stderr, "kernel_launch: grid %d (cus %d, per_cu %d)\n", grid, cus, per_cu);
    }
    if (grid < 0) return;
    Args a{};
    for (int i = 0; i < 18; ++i) a.in[i] = (const float*)d_in[i];
    a.out = (float*)d_out; a.ws = (unsigned char*)d_ws;
    if (N_LAUNCH_MODE == 1) {
        a.ph_lo = 0; a.ph_hi = 13;
        if (hipMemsetAsync((unsigned char*)d_ws + WS_BAR, 0, XCD_BAR_WORDS * 4, stream) != hipSuccess) { fprintf(stderr, "kernel_launch: memset of the barrier words failed\n"); return; }
        void* kargs[] = {&a};
        hipError_t e = hipLaunchCooperativeKernel((const void*)fwd_kernel, dim3(grid), dim3(NTHREADS), kargs, LDS_BYTES, stream);
        if (e != hipSuccess) fprintf(stderr, "cooperative launch failed: %s (grid %d)\n", hipGetErrorString(e), grid);
    } else {
        for (int p = 0; p < 13; ++p) { a.ph_lo = p; a.ph_hi = p + 1; hipLaunchKernelGGL(fwd_kernel, dim3(grid), dim3(NTHREADS), LDS_BYTES, stream, a); }
    }
}
```

```cpp
#include <hip/hip_runtime.h>
#include <hip/hip_cooperative_groups.h>
#include <cstdio>
#include <cstdint>
namespace cg = cooperative_groups;
namespace pg8 {
#define PG8_LAS __attribute__((address_space(3)))
typedef unsigned short bf16_t;
typedef short bf16x8 __attribute__((ext_vector_type(8)));
typedef float f32x4 __attribute__((ext_vector_type(4)));
typedef unsigned u32x4 __attribute__((ext_vector_type(4)));
constexpr int BM = 256, BK = 64, HALF = 128, HTB = HALF * BK * 2  , STAGE_BYTES = 8 * HTB, NXCD = 8, WGM = 8;

__host__ __device__ __forceinline__ int lds_byte(int r, int c) { const int st = (r >> 4) * 2 + (c >> 5), rr = r & 15, cc = c & 31, ob = rr * 64 + cc * 2; return st * 1024 + (ob ^ (((ob >> 9) & 1) << 5)); }
__host__ __device__ __forceinline__ void stage_rc(int b, int& R, int& C) { const int st = b / 1024, sb = b % 1024, swz = sb ^ (((sb >> 9) & 1) << 5); R = (st >> 1) * 16 + swz / 64; C = (st & 1) * 32 + (swz % 64) / 2; }
__host__ __device__ __forceinline__ int perm32(int rho) { const int n = rho >> 4, i = rho & 15; return 8 * (i >> 2) + 4 * n + (i & 3); }

struct Unit { int pm, pn; };
struct Gemm { const bf16_t* A; const bf16_t* Bt; int M, N, K, lda, ldb; };

struct StaticOrder {
    int nM, nN, nwg, G, c;
    __host__ __device__ void init(int M, int N, int G_, int c_) { nM = M / BM; nN = N / BM; nwg = nM * nN; G = G_; c = c_; }
    __host__ __device__ bool next(int i, Unit& u) const {
        const long L = (long)i * G + c; if (L >= nwg) return false;
        int wgid = (int)L; { const int q = nwg / NXCD, r = nwg % NXCD, xcd = wgid % NXCD, off = wgid / NXCD; wgid = (xcd < r ? xcd * (q + 1) : r * (q + 1) + (xcd - r) * q) + off; }
        const int nig = WGM * nN, gid = wgid / nig, fm = gid * WGM, gsz = (nM - fm) < WGM ? (nM - fm) : WGM;
        u.pm = fm + ((wgid % nig) % gsz); u.pn = (wgid % nig) / gsz; return true;
    }
    __device__ __forceinline__ void a_ready(const Unit&) const {}
    __device__ __forceinline__ void done(const Unit&) const {}
};

__device__ __forceinline__ unsigned cvt_pk_bf16(float lo, float hi) { unsigned r; asm volatile("v_cvt_pk_bf16_f32 %0, %1, %2" : "=v"(r) : "v"(lo), "v"(hi)); return r; }
typedef float f32x2 __attribute__((ext_vector_type(2)));
typedef unsigned u32x2 __attribute__((ext_vector_type(2)));
__device__ __forceinline__ void st16_wt(void* p, u32x4 v) { asm volatile("global_store_dwordx4 %0, %1, off sc1\n\ts_nop 1" :: "v"(p), "v"(v) : "memory"); }
constexpr int PP = 4128;
constexpr float EPSN = 1e-6f;
constexpr int ACT_LD = 4160;
__device__ __forceinline__ float rstd_of(float ss) { return rsqrtf(ss * (1.0f / 1024.0f) + EPSN); }
struct EpiQKV {
    static constexpr bool PERM = true, AFTER_DRAIN = false;
    bf16_t* Q; bf16_t* Kb; bf16_t* Vt; const float* rowss; float qscale; const PG8_LAS float* rst; int nrst; PG8_LAS unsigned char* tl; mutable int ui = 0;
    __device__ __forceinline__ void operator()(const f32x4 (&acc)[2][2][4][2], const Unit& u, int wr, int wc, int fr, int fq) const {
        const int colt = u.pn * BM; const int which = colt >> 10; const int cbase = (colt & 1023) + wc * 32 + 8 * fq;
#pragma unroll
        for (int ai = 0; ai < 2; ++ai)
#pragma unroll
            for (int m = 0; m < 4; ++m) {
                const int row = u.pm * BM + ai * HALF + wr * 64 + m * 16 + fr;
                const int b = row >> 12, pos = (row & 4095) + 16;
                float rs = rst[ui * 256 + ai * HALF + wr * 64 + m * 16 + fr]; if (which == 0) rs *= qscale;
#pragma unroll
                for (int bj = 0; bj < 2; ++bj) {
                    const int c = cbase + bj * HALF; const int head = c >> 6, d = c & 63;
                    const f32x4 v0 = acc[ai][bj][m][0] * rs, v1 = acc[ai][bj][m][1] * rs;
                    u32x4 w; w.x = cvt_pk_bf16(v0[0], v0[1]); w.y = cvt_pk_bf16(v0[2], v0[3]); w.z = cvt_pk_bf16(v1[0], v1[1]); w.w = cvt_pk_bf16(v1[2], v1[3]);
                    if (which < 2) {
                        bf16_t* dst = (which == 0 ? Q : Kb) + ((size_t)((b * 16 + head) * PP + pos)) * 64 + d;
                        *(u32x4*)dst = w;
                    } else {
                        PG8_LAS bf16_t* T = (PG8_LAS bf16_t*)(tl + (wr * 4 + wc) * 1536);
                        const int rb = 8 * fq * 24 + fr;
                        T[rb] = (bf16_t)(w.x & 0xffffu); T[rb + 24] = (bf16_t)(w.x >> 16); T[rb + 48] = (bf16_t)(w.y & 0xffffu); T[rb + 72] = (bf16_t)(w.y >> 16);
                        T[rb + 96] = (bf16_t)(w.z & 0xffffu); T[rb + 120] = (bf16_t)(w.z >> 16); T[rb + 144] = (bf16_t)(w.w & 0xffffu); T[rb + 168] = (bf16_t)(w.w >> 16);
                        const int L = fq * 16 + fr, dl = L >> 1, hf = L & 1;
                        const u32x4 tv = *(const PG8_LAS u32x4*)(T + dl * 24 + hf * 8);
                        const int pos0 = ((u.pm * BM + ai * HALF + wr * 64 + m * 16) & 4095) + 16;
                        const int dbase = (c & 63) - 8 * fq;
                        *(u32x4*)(Vt + ((size_t)((b * 16 + head) * 64 + dbase + dl)) * PP + pos0 + 8 * hf) = tv;
                    }
                }
            }
        ++ui;
    }
};
__device__ __forceinline__ float bflo(unsigned w) { return __builtin_bit_cast(float, w << 16); }
__device__ __forceinline__ float bfhi(unsigned w) { return __builtin_bit_cast(float, w & 0xffff0000u); }
struct EpiResid {
    static constexpr bool PERM = true, AFTER_DRAIN = false;
    bf16_t* hb; float* rowss_out;
    __device__ __forceinline__ void operator()(const f32x4 (&acc)[2][2][4][2], const Unit& u, int wr, int wc, int fr, int fq) const {
        const int col0 = u.pn * BM + wc * 32 + 8 * fq;
        u32x4 old[2][4][2];
#pragma unroll
        for (int ai = 0; ai < 2; ++ai)
#pragma unroll
            for (int m = 0; m < 4; ++m)
#pragma unroll
                for (int bj = 0; bj < 2; ++bj) old[ai][m][bj] = *(const u32x4*)(hb + (size_t)(u.pm * BM + ai * HALF + wr * 64 + m * 16 + fr) * 1024 + col0 + bj * HALF);
#pragma unroll
        for (int ai = 0; ai < 2; ++ai)
#pragma unroll
            for (int m = 0; m < 4; ++m) {
                const int row = u.pm * BM + ai * HALF + wr * 64 + m * 16 + fr; float ss = 0.f;
#pragma unroll
                for (int bj = 0; bj < 2; ++bj) {
                    const u32x4 ov = old[ai][m][bj]; const f32x4 a0 = acc[ai][bj][m][0], a1 = acc[ai][bj][m][1];
                    u32x4 w;
                    w.x = cvt_pk_bf16(bflo(ov.x) + a0[0], bfhi(ov.x) + a0[1]); w.y = cvt_pk_bf16(bflo(ov.y) + a0[2], bfhi(ov.y) + a0[3]);
                    w.z = cvt_pk_bf16(bflo(ov.z) + a1[0], bfhi(ov.z) + a1[1]); w.w = cvt_pk_bf16(bflo(ov.w) + a1[2], bfhi(ov.w) + a1[3]);
                    *(u32x4*)(hb + (size_t)row * 1024 + col0 + bj * HALF) = w;
#pragma unroll
                    for (int e = 0; e < 4; ++e) { const float lo = bflo(w[e]), hi = bfhi(w[e]); ss += lo * lo + hi * hi; }
                }
                ss += __shfl_xor(ss, 16); ss += __shfl_xor(ss, 32);
                if (fq == 0) atomicAdd(rowss_out + row, ss);
            }
    }
};
struct EpiFinal {
    static constexpr bool PERM = false, AFTER_DRAIN = true;
    const bf16_t* hb; float* rowss; float* out; const float* gfin; unsigned* cnt;
    __device__ __forceinline__ void fused(f32x4 (&acc)[2][2][4][2], const Unit& u, int wr, int wc, int fr, int fq, PG8_LAS unsigned char* lds, int wid, int lane) const {
        const int col0 = u.pn * BM + wc * 32 + 4 * fq;
        u32x2 old[2][4][2][2];
#pragma unroll
        for (int ai = 0; ai < 2; ++ai)
#pragma unroll
            for (int m = 0; m < 4; ++m)
#pragma unroll
                for (int bj = 0; bj < 2; ++bj)
#pragma unroll
                    for (int n = 0; n < 2; ++n) old[ai][m][bj][n] = *(const u32x2*)(hb + (size_t)(u.pm * BM + ai * HALF + wr * 64 + m * 16 + fr) * 1024 + col0 + bj * HALF + n * 16);
        f32x4 gv[2][2];
#pragma unroll
        for (int bj = 0; bj < 2; ++bj)
#pragma unroll
            for (int n = 0; n < 2; ++n) gv[bj][n] = *(const f32x4*)(gfin + col0 + bj * HALF + n * 16);
#pragma unroll
        for (int ai = 0; ai < 2; ++ai)
#pragma unroll
            for (int m = 0; m < 4; ++m) {
                const int row = u.pm * BM + ai * HALF + wr * 64 + m * 16 + fr; float ss = 0.f;
#pragma unroll
                for (int bj = 0; bj < 2; ++bj)
#pragma unroll
                    for (int n = 0; n < 2; ++n) { const u32x2 ov = old[ai][m][bj][n]; f32x4 v = acc[ai][bj][m][n];
                        v[0] += bflo(ov.x); v[1] += bfhi(ov.x); v[2] += bflo(ov.y); v[3] += bfhi(ov.y); acc[ai][bj][m][n] = v;
                        ss += (v[0] * v[0] + v[1] * v[1]) + (v[2] * v[2] + v[3] * v[3]); }
                ss += __shfl_xor(ss, 16); ss += __shfl_xor(ss, 32);
                if (fq == 0) __hip_atomic_fetch_add(rowss + row, ss, __ATOMIC_RELAXED, __HIP_MEMORY_SCOPE_AGENT);
            }
        asm volatile("s_waitcnt vmcnt(0)" ::: "memory");
        asm volatile("s_barrier" ::: "memory");
        if (wid == 0 && lane == 0) {
            __hip_atomic_fetch_add(cnt + u.pm, 1u, __ATOMIC_RELAXED, __HIP_MEMORY_SCOPE_AGENT);
            unsigned spins = 0;
            while (__hip_atomic_load(cnt + u.pm, __ATOMIC_RELAXED, __HIP_MEMORY_SCOPE_AGENT) < 4u) { __builtin_amdgcn_s_sleep(2); if (++spins > (1u << 22)) break; }
        }
        asm volatile("s_waitcnt vmcnt(0) lgkmcnt(0)\n\ts_barrier" ::: "memory");
        float ssv[2][4];
#pragma unroll
        for (int ai = 0; ai < 2; ++ai)
#pragma unroll
            for (int m = 0; m < 4; ++m) ssv[ai][m] = __hip_atomic_load(rowss + u.pm * BM + ai * HALF + wr * 64 + m * 16 + fr, __ATOMIC_RELAXED, __HIP_MEMORY_SCOPE_AGENT);
#pragma unroll
        for (int ai = 0; ai < 2; ++ai)
#pragma unroll
            for (int m = 0; m < 4; ++m) {
                const int row = u.pm * BM + ai * HALF + wr * 64 + m * 16 + fr;
                const float rs = rstd_of(ssv[ai][m]);
#pragma unroll
                for (int bj = 0; bj < 2; ++bj)
#pragma unroll
                    for (int n = 0; n < 2; ++n) *(f32x4*)(out + (size_t)row * 1024 + col0 + bj * HALF + n * 16) = acc[ai][bj][m][n] * rs * gv[bj][n];
            }
    }
};
struct EpiNull {
    static constexpr bool PERM = true, AFTER_DRAIN = false;
    float* dummy;
    __device__ __forceinline__ void operator()(const f32x4 (&acc)[2][2][4][2], const Unit& u, int wr, int wc, int fr, int fq) const {
        f32x4 s = {0.f, 0.f, 0.f, 0.f};
#pragma unroll
        for (int ai = 0; ai < 2; ++ai)
#pragma unroll
            for (int bj = 0; bj < 2; ++bj)
#pragma unroll
                for (int m = 0; m < 4; ++m)
#pragma unroll
                    for (int n = 0; n < 2; ++n) s += acc[ai][bj][m][n];
        dummy[(size_t)blockIdx.x * 512 + threadIdx.x] = (s[0] + s[1]) + (s[2] + s[3]);
    }
};
struct EpiUp {
    static constexpr bool PERM = true, AFTER_DRAIN = false;
    bf16_t* O; const float* rowss; const PG8_LAS float* rst; int nrst; mutable int ui = 0;
    __device__ __forceinline__ void operator()(const f32x4 (&acc)[2][2][4][2], const Unit& u, int wr, int wc, int fr, int fq) const {
        const int col0 = u.pn * BM + wc * 32 + 8 * fq;
#pragma unroll
        for (int ai = 0; ai < 2; ++ai)
#pragma unroll
            for (int m = 0; m < 4; ++m) {
                const int row = u.pm * BM + ai * HALF + wr * 64 + m * 16 + fr; const float rs = rst[ui * 256 + ai * HALF + wr * 64 + m * 16 + fr];
#pragma unroll
                for (int bj = 0; bj < 2; ++bj) {
                    f32x4 v0 = acc[ai][bj][m][0] * rs, v1 = acc[ai][bj][m][1] * rs;
#pragma unroll
                    for (int e = 0; e < 4; ++e) { const float a = fmaxf(v0[e], 0.f), b = fmaxf(v1[e], 0.f); v0[e] = a * a; v1[e] = b * b; }
                    u32x4 w; w.x = cvt_pk_bf16(v0[0], v0[1]); w.y = cvt_pk_bf16(v0[2], v0[3]); w.z = cvt_pk_bf16(v1[0], v1[1]); w.w = cvt_pk_bf16(v1[2], v1[3]);
                    st16_wt(O + (size_t)row * ACT_LD + col0 + bj * HALF, w);
                }
            }
        ++ui;
    }
};
__device__ __forceinline__ float gelu_tanh(float x) {
    const float y = 0.7978845608028654f * (x + 0.044715f * x * x * x);
    return x * __builtin_amdgcn_rcpf(1.0f + __builtin_amdgcn_exp2f(-2.0f * 1.4426950408889634f * y));
}
struct EpiWin {
    static constexpr bool PERM = true, AFTER_DRAIN = false;
    bf16_t* G; bf16_t* R; const float* rowss; const PG8_LAS float* rst; int nrst; mutable int ui = 0;
    __device__ __forceinline__ void operator()(const f32x4 (&acc)[2][2][4][2], const Unit& u, int wr, int wc, int fr, int fq) const {
        const int colt = u.pn * BM; const bool isgate = colt < 1024; const int col0 = (colt & 1023) + wc * 32 + 8 * fq; bf16_t* dstb = isgate ? G : R;
#pragma unroll
        for (int ai = 0; ai < 2; ++ai)
#pragma unroll
            for (int m = 0; m < 4; ++m) {
                const int row = u.pm * BM + ai * HALF + wr * 64 + m * 16 + fr; const float rs = rst[ui * 256 + ai * HALF + wr * 64 + m * 16 + fr];
#pragma unroll
                for (int bj = 0; bj < 2; ++bj) {
                    f32x4 v0 = acc[ai][bj][m][0] * rs, v1 = acc[ai][bj][m][1] * rs;
                    if (isgate) {
#pragma unroll
                        for (int e = 0; e < 4; ++e) { v0[e] = gelu_tanh(v0[e]); v1[e] = gelu_tanh(v1[e]); }
                    }
                    u32x4 w; w.x = cvt_pk_bf16(v0[0], v0[1]); w.y = cvt_pk_bf16(v0[2], v0[3]); w.z = cvt_pk_bf16(v1[0], v1[1]); w.w = cvt_pk_bf16(v1[2], v1[3]);
                    *(u32x4*)(dstb + (size_t)row * 1024 + col0 + bj * HALF) = w;
                }
            }
        ++ui;
    }
};
template <class Epi, class Sched, bool ALIGN_EPI = false, bool SP2 = false>
__device__ __forceinline__ void gemm_phase(PG8_LAS unsigned char* lds, const Gemm g, const Sched& S, const Epi& E) {
    const int tid = threadIdx.x, wid = __builtin_amdgcn_readfirstlane(tid >> 6), lane = tid & 63, wr = wid >> 2, wc = wid & 3, fr = lane & 15, fq = lane >> 4;
    const int K = g.K, nt = K / BK;
    unsigned voffA[2], voffB[2];
#pragma unroll
    for (int i = 0; i < 2; ++i) { int R, C; stage_rc(tid * 16 + i * 8192, R, C); const int Rb = Epi::PERM ? ((R & ~31) + perm32(R & 31)) : R;
        voffA[i] = (unsigned)(R * g.lda + C) * 2u; voffB[i] = (unsigned)(Rb * g.ldb + C) * 2u; }
    const size_t kstep = (size_t)(BK * 2);
    const size_t hstepA = (size_t)HALF * g.lda * 2, hstepB = (size_t)HALF * g.ldb * 2;
    const size_t tstepA = 2 * hstepA, tstepB = 2 * hstepB;
    const unsigned ldsw = (unsigned)wid * 1024u;
    const int aoff = lds_byte(wr * 64 + fr, fq * 8), boff = lds_byte(wc * 32 + fr, fq * 8);
#define PG8_SA(b, h) (((b) * 2 + (h)) * HTB)
#define PG8_SB(b, h) ((4 + (b) * 2 + (h)) * HTB)
#define PG8_STAGE(bufoff, gbase, voff) do { _Pragma("unroll") for (int _i = 0; _i < 2; ++_i) \
        __builtin_amdgcn_global_load_lds((const unsigned*)((const char*)(gbase) + (voff)[_i]), (PG8_LAS unsigned*)(lds + (bufoff) + ldsw + _i * 8192), 16, 0, 0); } while (0)
#define PG8_LDA(dst, b, h) do { _Pragma("unroll") for (int m = 0; m < 4; ++m) _Pragma("unroll") for (int k = 0; k < 2; ++k) dst[m][k] = *(const PG8_LAS bf16x8*)(lds + PG8_SA(b, h) + aoff + m * 2048 + k * 1024); } while (0)
#define PG8_LDB(dst, b, h) do { _Pragma("unroll") for (int n = 0; n < 2; ++n) _Pragma("unroll") for (int k = 0; k < 2; ++k) dst[n][k] = *(const PG8_LAS bf16x8*)(lds + PG8_SB(b, h) + boff + n * 2048 + k * 1024); } while (0)
#define PG8_MMA(ai, bj, At, Bt) do { __builtin_amdgcn_s_setprio(1); _Pragma("unroll") for (int m = 0; m < 4; ++m) _Pragma("unroll") for (int n = 0; n < 2; ++n) _Pragma("unroll") for (int k = 0; k < 2; ++k) \
        acc[ai][bj][m][n] = __builtin_amdgcn_mfma_f32_16x16x32_bf16(Bt[n][k], At[m][k], acc[ai][bj][m][n], 0, 0, 0); __builtin_amdgcn_s_setprio(0); } while (0)
#define PG8_WAIT_V(n) asm volatile("s_waitcnt vmcnt(" #n ")" ::: "memory")
#define PG8_WAIT_L(n) asm volatile("s_waitcnt lgkmcnt(" #n ")" ::: "memory")
#define PG8_BAR __builtin_amdgcn_s_barrier()
#define PG8_SCHED __builtin_amdgcn_sched_barrier(0)
    Unit cur, nxt; int ui = 0;
    if (!S.next(0, cur)) return;
    f32x4 acc[2][2][4][2];
#pragma unroll
    for (int a = 0; a < 2; ++a)
#pragma unroll
        for (int b = 0; b < 2; ++b)
#pragma unroll
            for (int m = 0; m < 4; ++m)
#pragma unroll
                for (int n = 0; n < 2; ++n) acc[a][b][m][n] = (f32x4){0.f, 0.f, 0.f, 0.f};
    bf16x8 At[4][2], B0[2][2], B1[2][2];
    const char* cA = (const char*)g.A + (size_t)cur.pm * tstepA; const char* cB = (const char*)g.Bt + (size_t)cur.pn * tstepB;
    S.a_ready(cur);
    if constexpr (SP2) {
        PG8_STAGE(PG8_SB(0, 0), cB, voffB); PG8_STAGE(PG8_SB(0, 1), cB + hstepB, voffB); PG8_STAGE(PG8_SA(0, 0), cA, voffA); PG8_STAGE(PG8_SA(0, 1), cA + hstepA, voffA);
        if (wr == 1) PG8_BAR;
        PG8_WAIT_V(2); PG8_BAR;
        PG8_STAGE(PG8_SB(1, 0), cB + kstep, voffB); PG8_STAGE(PG8_SA(1, 0), cA + kstep, voffA); PG8_STAGE(PG8_SB(1, 1), cB + hstepB + kstep, voffB);
        PG8_WAIT_V(6); PG8_BAR;
    } else {
        PG8_STAGE(PG8_SB(0, 0), cB, voffB); PG8_STAGE(PG8_SA(0, 0), cA, voffA); PG8_STAGE(PG8_SB(0, 1), cB + hstepB, voffB); PG8_STAGE(PG8_SA(0, 1), cA + hstepA, voffA);
        if (wr == 1) PG8_BAR;
        PG8_WAIT_V(4); PG8_BAR;
        PG8_STAGE(PG8_SB(1, 0), cB + kstep, voffB); PG8_STAGE(PG8_SA(1, 0), cA + kstep, voffA); PG8_STAGE(PG8_SB(1, 1), cB + hstepB + kstep, voffB);
        PG8_WAIT_V(6); PG8_BAR;
    }
    for (;;) {
        const bool has_next = S.next(ui + 1, nxt);
        const char* nA = has_next ? (const char*)g.A + (size_t)nxt.pm * tstepA : cA; const char* nB = has_next ? (const char*)g.Bt + (size_t)nxt.pn * tstepB : cB;
        for (int t = 0; t < nt; t += 2) {
            const bool last = (t == nt - 2);
            const char* a1 = cA + (size_t)(t + 1) * kstep;
            const char* a2 = last ? nA : cA + (size_t)(t + 2) * kstep; const char* b2 = last ? nB : cB + (size_t)(t + 2) * kstep;
            const char* a3 = a2 + kstep; const char* b3 = b2 + kstep;
            if (last && has_next) S.a_ready(nxt);
            if constexpr (SP2) {
            PG8_LDB(B0, 0, 0); PG8_LDB(B1, 0, 1); PG8_SCHED; PG8_LDA(At, 0, 0); PG8_STAGE(PG8_SA(1, 1), a1 + hstepA, voffA);
            PG8_WAIT_V(8); PG8_WAIT_L(0); PG8_BAR; PG8_MMA(0, 0, At, B0); PG8_MMA(0, 1, At, B1); PG8_BAR; PG8_SCHED;
            PG8_LDA(At, 0, 1); PG8_STAGE(PG8_SB(0, 0), b2, voffB); PG8_STAGE(PG8_SB(0, 1), b2 + hstepB, voffB); PG8_STAGE(PG8_SA(0, 0), a2, voffA);
            PG8_WAIT_V(8); PG8_WAIT_L(0); PG8_BAR; PG8_MMA(1, 0, At, B0); PG8_MMA(1, 1, At, B1); PG8_BAR; PG8_SCHED;
            PG8_LDB(B0, 1, 0); PG8_LDB(B1, 1, 1); PG8_SCHED; PG8_LDA(At, 1, 0); PG8_STAGE(PG8_SA(0, 1), a2 + hstepA, voffA);
            PG8_WAIT_V(8); PG8_WAIT_L(0); PG8_BAR; PG8_MMA(0, 0, At, B0); PG8_MMA(0, 1, At, B1); PG8_BAR; PG8_SCHED;
            PG8_LDA(At, 1, 1); PG8_STAGE(PG8_SB(1, 0), b3, voffB); PG8_STAGE(PG8_SB(1, 1), b3 + hstepB, voffB); PG8_STAGE(PG8_SA(1, 0), a3, voffA);
            PG8_WAIT_V(8); PG8_WAIT_L(0); PG8_BAR; PG8_MMA(1, 0, At, B0); PG8_MMA(1, 1, At, B1); PG8_BAR; PG8_SCHED;
            } else {
            PG8_LDB(B0, 0, 0); PG8_SCHED; PG8_LDA(At, 0, 0); PG8_STAGE(PG8_SA(1, 1), a1 + hstepA, voffA);
            PG8_WAIT_L(8); PG8_BAR; PG8_WAIT_L(0); PG8_MMA(0, 0, At, B0); PG8_BAR; PG8_SCHED;
            PG8_LDB(B1, 0, 1); PG8_STAGE(PG8_SB(0, 0), b2, voffB);
            PG8_BAR; PG8_WAIT_L(0); PG8_MMA(0, 1, At, B1); PG8_BAR;
            PG8_LDA(At, 0, 1); PG8_STAGE(PG8_SA(0, 0), a2, voffA);
            PG8_BAR; PG8_WAIT_L(0); PG8_MMA(1, 0, At, B0); PG8_BAR; PG8_SCHED;
            PG8_STAGE(PG8_SB(0, 1), b2 + hstepB, voffB);
            PG8_WAIT_V(6); PG8_BAR; PG8_MMA(1, 1, At, B1); PG8_BAR;
            PG8_LDB(B0, 1, 0); PG8_SCHED; PG8_LDA(At, 1, 0); PG8_STAGE(PG8_SA(0, 1), a2 + hstepA, voffA);
            PG8_WAIT_L(8); PG8_BAR; PG8_WAIT_L(0); PG8_MMA(0, 0, At, B0); PG8_BAR; PG8_SCHED;
            PG8_LDB(B1, 1, 1); PG8_STAGE(PG8_SB(1, 0), b3, voffB);
            PG8_BAR; PG8_WAIT_L(0); PG8_MMA(0, 1, At, B1); PG8_BAR;
            PG8_LDA(At, 1, 1); PG8_STAGE(PG8_SA(1, 0), a3, voffA);
            PG8_BAR; PG8_WAIT_L(0); PG8_MMA(1, 0, At, B0); PG8_BAR; PG8_SCHED;
            PG8_STAGE(PG8_SB(1, 1), b3 + hstepB, voffB);
            PG8_WAIT_V(6); PG8_BAR; PG8_MMA(1, 1, At, B1); PG8_BAR;
            }
        }
        if constexpr (ALIGN_EPI) { if (wr == 0) PG8_BAR; }
        if constexpr (!Epi::AFTER_DRAIN) { E(acc, cur, wr, wc, fr, fq); S.done(cur); }
        if (!has_next) break;
#pragma unroll
        for (int a = 0; a < 2; ++a)
#pragma unroll
            for (int b = 0; b < 2; ++b)
#pragma unroll
                for (int m = 0; m < 4; ++m)
#pragma unroll
                    for (int n = 0; n < 2; ++n) acc[a][b][m][n] = (f32x4){0.f, 0.f, 0.f, 0.f};
        cur = nxt; cA = nA; cB = nB; ++ui;
        if constexpr (ALIGN_EPI) { if (wr == 1) PG8_BAR; }
    }
    PG8_WAIT_V(0);
    if constexpr (!ALIGN_EPI) { if (wr == 0) PG8_BAR; }
    PG8_BAR;
    if constexpr (Epi::AFTER_DRAIN) { E.fused(acc, cur, wr, wc, fr, fq, lds, wid, lane); S.done(cur); }
#undef PG8_SA
#undef PG8_SB
#undef PG8_STAGE
#undef PG8_LDA
#undef PG8_LDB
#undef PG8_MMA
#undef PG8_WAIT_V
#undef PG8_WAIT_L
#undef PG8_BAR
#undef PG8_SCHED
}
}
#define LAS __attribute__((address_space(3)))
typedef unsigned short bf16;
typedef float f32x4 __attribute__((ext_vector_type(4)));
typedef float f32x16 __attribute__((ext_vector_type(16)));
typedef short bf16x8 __attribute__((ext_vector_type(8)));
typedef unsigned u32x4 __attribute__((ext_vector_type(4)));
typedef unsigned u32x2 __attribute__((ext_vector_type(2)));
constexpr int NWAVES = 8, NTHREADS = 512;
constexpr int NREAL = 16384, MBASE = 16384, MALLOC = 16448, DM = 1024, FF = 4096, PP = pg8::PP;
constexpr float QSCALE = 0.125f * 1.4426950408889634f;
constexpr size_t MiB = 1u << 20;
constexpr size_t WS_ROWSS = 0;
constexpr size_t WS_HMETA = 512 * 1024;
constexpr size_t WS_HMEND = 640 * 1024;
constexpr size_t WS_PCNT = 704 * 1024;
constexpr size_t WS_SFLAG = 736 * 1024;
constexpr size_t WS_BAR = 768 * 1024;
constexpr size_t WS_CARA = 1 * MiB, WS_CARB = 2 * MiB;
constexpr int ACT_LD = pg8::ACT_LD;
constexpr size_t KiB256 = 256 * 1024;
constexpr size_t WS_WQKV = 4 * MiB, WS_WO = 10 * MiB, WS_WUP0 = 12 * MiB, WS_WDN0 = 20 * MiB, WS_WIN = 28 * MiB + KiB256, WS_WRG = 32 * MiB + KiB256, WS_WIG = 32 * MiB + 2 * KiB256,
                 WS_WOUT = 33 * MiB + KiB256, WS_WUP1 = 35 * MiB + KiB256, WS_WDN1 = 43 * MiB + KiB256;
static_assert(WS_WDN0 + (size_t)1024 * ACT_LD * 2 <= WS_WIN && WS_WDN1 + (size_t)1024 * ACT_LD * 2 <= 52 * MiB, "weight map");
constexpr size_t WS_HB = 52 * MiB;
constexpr size_t WS_A = 85 * MiB;
constexpr size_t QKV_BYTES = (size_t)64 * PP * 64 * 2;
constexpr size_t ROWARR = (size_t)MALLOC * 1024 * 2;
constexpr size_t WS_Q = WS_A, WS_K = WS_A + QKV_BYTES, WS_VT = WS_A + 2 * QKV_BYTES, WS_O = WS_A + 3 * QKV_BYTES;
constexpr size_t WS_ACT = WS_A;
constexpr size_t WS_GATE = WS_A, WS_REC = WS_A + ROWARR, WS_HL = WS_A + 2 * ROWARR, WS_PC = WS_A + 3 * ROWARR;
constexpr size_t WS_Y = 216 * MiB;
constexpr size_t WS_END = WS_Y + ROWARR;
static_assert(WS_O + ROWARR <= WS_Y && WS_ACT + (size_t)(MBASE + 16) * ACT_LD * 2 <= WS_Y && WS_PC + ROWARR <= WS_Y && WS_END <= 256 * MiB, "ws map");
constexpr int LDS_BYTES = 163840;

struct Args {
    const float* in[18]; float* out; unsigned char* ws; int ph_lo, ph_hi;
};

__device__ __forceinline__ unsigned f2bf(float f) { unsigned u = __builtin_bit_cast(unsigned, f); return (u + 0x7fffu + ((u >> 16) & 1u)) >> 16; }
__device__ __forceinline__ unsigned pk2(float lo, float hi) { return f2bf(lo) | (f2bf(hi) << 16); }
__device__ __forceinline__ float bf2f(unsigned short v) { return __builtin_bit_cast(float, (unsigned)v << 16); }
__device__ __forceinline__ float wave_sum(float v) {
#pragma unroll
    for (int o = 1; o < 64; o <<= 1) v += __shfl_xor(v, o);
    return v;
}
__device__ __forceinline__ void p0_transpose_item(const float* W, int K, int N, bf16* WT, const float* gain, float* scr, int item, int lane, int ldt = 0) {
    if (ldt == 0) ldt = K;
    const int nblk = N / 32, kb = item / nblk, nb = item % nblk, k0 = 64 * kb, n0 = 32 * nb;
    {
        const int rr = lane >> 3, c4 = (lane & 7) * 4;
        f32x4 v[8];
#pragma unroll
        for (int i = 0; i < 8; ++i) v[i] = *(const f32x4*)(W + (size_t)(k0 + 8 * i + rr) * N + n0 + c4);
#pragma unroll
        for (int i = 0; i < 8; ++i) { const int kk = 8 * i + rr; const float gk = gain ? gain[k0 + kk] : 1.0f;
            scr[kk * 33 + c4] = v[i][0] * gk; scr[kk * 33 + c4 + 1] = v[i][1] * gk; scr[kk * 33 + c4 + 2] = v[i][2] * gk; scr[kk * 33 + c4 + 3] = v[i][3] * gk; }
    }
    asm volatile("s_waitcnt lgkmcnt(0)" ::: "memory");
    const int c = lane & 7;
#pragma unroll
    for (int j = 0; j < 4; ++j) { const int n = (lane >> 3) + 8 * j; const float* s = scr + (8 * c) * 33 + n;
        u32x4 o; o.x = pk2(s[0 * 33], s[1 * 33]); o.y = pk2(s[2 * 33], s[3 * 33]); o.z = pk2(s[4 * 33], s[5 * 33]); o.w = pk2(s[6 * 33], s[7 * 33]);
        *(u32x4*)(WT + (size_t)(n0 + n) * ldt + k0 + 8 * c) = o; }
    asm volatile("s_waitcnt lgkmcnt(0)" ::: "memory");
}
__device__ __forceinline__ void prologue(const Args& a, unsigned char* lds, int gw, int NGW, int wid, int lane) {
    unsigned char* ws = a.ws;
    float* scr = (float*)(lds + wid * 16384);
    const float* norm_mix = a.in[2]; const float* norm_mlp = a.in[3];
    constexpr int I_QKV = 16 * 96, I_O = 16 * 32, I_UP = 16 * 128, I_DN = 64 * 32, I_IN = 16 * 64, I_G = 2 * 4;
    constexpr int NITEMS = I_QKV + I_O + 2 * I_UP + 2 * I_DN + I_IN + 16 * I_G + I_O;
    for (int it = gw; it < NITEMS; it += NGW) {
        int r = it;
        if (r < I_QKV) { p0_transpose_item(a.in[4], 1024, 3072, (bf16*)(ws + WS_WQKV), norm_mix, scr, r, lane); continue; } r -= I_QKV;
        if (r < I_O) { p0_transpose_item(a.in[5], 1024, 1024, (bf16*)(ws + WS_WO), nullptr, scr, r, lane); continue; } r -= I_O;
        if (r < I_UP) { p0_transpose_item(a.in[15], 1024, 4096, (bf16*)(ws + WS_WUP0), norm_mlp, scr, r, lane); continue; } r -= I_UP;
        if (r < I_UP) { p0_transpose_item(a.in[15] + (size_t)1024 * 4096, 1024, 4096, (bf16*)(ws + WS_WUP1), norm_mlp + 1024, scr, r, lane); continue; } r -= I_UP;
        if (r < I_DN) { p0_transpose_item(a.in[16], 4096, 1024, (bf16*)(ws + WS_WDN0), nullptr, scr, r, lane, ACT_LD); continue; } r -= I_DN;
        if (r < I_DN) { p0_transpose_item(a.in[16] + (size_t)4096 * 1024, 4096, 1024, (bf16*)(ws + WS_WDN1), nullptr, scr, r, lane, ACT_LD); continue; } r -= I_DN;
        if (r < I_IN) { p0_transpose_item(a.in[6], 1024, 2048, (bf16*)(ws + WS_WIN), norm_mix + 1024, scr, r, lane); continue; } r -= I_IN;
        if (r < 8 * I_G) { const int n = r / I_G; p0_transpose_item(a.in[9] + (size_t)n * 16384, 128, 128, (bf16*)(ws + WS_WRG) + (size_t)n * 16384, nullptr, scr, r % I_G, lane); continue; } r -= 8 * I_G;
        if (r < 8 * I_G) { const int n = r / I_G; p0_transpose_item(a.in[11] + (size_t)n * 16384, 128, 128, (bf16*)(ws + WS_WIG) + (size_t)n * 16384, nullptr, scr, r % I_G, lane); continue; } r -= 8 * I_G;
        p0_transpose_item(a.in[14], 1024, 1024, (bf16*)(ws + WS_WOUT), nullptr, scr, r, lane);
    }
    float* rowss = (float*)(ws + WS_ROWSS); bf16* hb = (bf16*)(ws + WS_HB);
    for (int m0 = 2 * gw; m0 < NREAL + 16; m0 += 2 * NGW) {
        f32x4 v[2][4];
#pragma unroll
        for (int k = 0; k < 2; ++k) { const int m = m0 + k; const float* src = (m < NREAL) ? a.in[0] + (size_t)m * 1024 : a.in[1] + (size_t)(m - NREAL) * 1024;
            const f32x4* xr = (const f32x4*)src + lane;
#pragma unroll
            for (int j = 0; j < 4; ++j) v[k][j] = xr[64 * j]; }
#pragma unroll
        for (int k = 0; k < 2; ++k) { const int m = m0 + k; float s = 0.f;
            unsigned long long* o8 = (unsigned long long*)(hb + (size_t)m * 1024) + lane;
#pragma unroll
            for (int j = 0; j < 4; ++j) { const f32x4 t = v[k][j]; s += (t.x * t.x + t.y * t.y) + (t.z * t.z + t.w * t.w);
                o8[64 * j] = (unsigned long long)pk2(t.x, t.y) | ((unsigned long long)pk2(t.z, t.w) << 32); }
            s = wave_sum(s); if (lane == 0) rowss[m] = s; }
    }
    for (int i = gw * 64 + lane; i < 4 * MALLOC; i += NGW * 64) rowss[MALLOC + i] = 0.f;
    if (gw == 0) ((unsigned*)(ws + WS_PCNT))[lane] = 0u;
    if (gw == 1) { unsigned* sf = (unsigned*)(ws + WS_SFLAG); sf[lane] = 0u; sf[64 + lane] = 0u; sf[128 + lane] = 0u; sf[192 + lane] = 0u; }
}

template <int K, int LD = K> __device__ __forceinline__ f32x4 skinny_tile(const bf16* A, const bf16* Bt, int n0, unsigned char* lds, int wid, int lane) {
    const int r = lane & 15, kq = lane >> 4; constexpr int ks = K >> 3, NS = ks / 32;
    const bf16* ap = A + (size_t)r * LD + wid * ks + 8 * kq; const bf16* bp = Bt + (size_t)(n0 + r) * LD + wid * ks + 8 * kq;
    bf16x8 av[NS], bv[NS];
#pragma unroll
    for (int k = 0; k < NS; ++k) { av[k] = *(const bf16x8*)(ap + 32 * k); bv[k] = *(const bf16x8*)(bp + 32 * k); }
    f32x4 acc = {0.f, 0.f, 0.f, 0.f};
#pragma unroll
    for (int k = 0; k < NS; ++k) acc = __builtin_amdgcn_mfma_f32_16x16x32_bf16(bv[k], av[k], acc, 0, 0, 0);
    f32x4* red = (f32x4*)lds;
    red[wid * 64 + lane] = acc;
    __syncthreads();
    f32x4 sum = {0.f, 0.f, 0.f, 0.f};
    if (wid == 0) {
#pragma unroll
        for (int w = 0; w < 8; ++w) sum += red[w * 64 + lane];
    }
    __syncthreads();
    return sum;
}
enum { SK_QKV = 0, SK_OPROJ = 1, SK_UP = 2, SK_DOWN = 3, SK_WIN = 4 };
template <int MODE> __device__ __forceinline__ void skinny_phase(const Args& a, unsigned char* lds, int G, int wid, int lane) {
    unsigned char* ws = a.ws; float* rowss = (float*)(ws + WS_ROWSS); bf16* hb = (bf16*)(ws + WS_HB); float* hmeta = (float*)(ws + WS_HMETA);
    constexpr int NIT = MODE == SK_QKV ? 192 : MODE == SK_UP ? 256 : 64;
    for (int item = blockIdx.x; item < NIT; item += G) {
        const int m = lane & 15, nq = lane >> 4, MR = MBASE + m;
        if (MODE == SK_QKV) {
            const int n0 = 16 * item; const f32x4 acc = skinny_tile<1024>(hb + (size_t)MBASE * 1024, (const bf16*)(ws + WS_WQKV), n0, lds, wid, lane);
            if (wid == 0) {
                const int n = n0 + 4 * nq, which = n >> 10, c = n & 1023, head = c >> 6, d = c & 63;
                float rs = pg8::rstd_of(rowss[MR]); if (which == 0) rs *= QSCALE;
                const unsigned w0 = pk2(acc[0] * rs, acc[1] * rs), w1 = pk2(acc[2] * rs, acc[3] * rs);
                for (int b = 0; b < 4; ++b) {
                    if (which < 2) { bf16* dst = (bf16*)(ws + (which == 0 ? WS_Q : WS_K)) + ((size_t)((b * 16 + head) * PP + m)) * 64 + d; u32x2 w; w.x = w0; w.y = w1; *(u32x2*)dst = w; }
                    else { bf16* dst = (bf16*)(ws + WS_VT) + ((size_t)((b * 16 + head) * 64 + d)) * PP + m;
                        dst[0] = (bf16)(w0 & 0xffffu); dst[PP] = (bf16)(w0 >> 16); dst[2 * PP] = (bf16)(w1 & 0xffffu); dst[3 * PP] = (bf16)(w1 >> 16); }
                }
            }
        } else if (MODE == SK_OPROJ || MODE == SK_DOWN) {
            const int n0 = 16 * item;
            const f32x4 acc = (MODE == SK_OPROJ) ? skinny_tile<1024>((const bf16*)(ws + WS_O) + (size_t)MBASE * 1024, (const bf16*)(ws + WS_WO), n0, lds, wid, lane)
                                                 : skinny_tile<4096, ACT_LD>((const bf16*)(ws + WS_ACT) + (size_t)MBASE * ACT_LD, (const bf16*)(ws + WS_WDN0), n0, lds, wid, lane);
            if (wid == 0) {
                const int n = n0 + 4 * nq; const float* base = (MODE == SK_OPROJ) ? a.in[1] : hmeta;
                const f32x4 o = *(const f32x4*)(base + m * 1024 + n) + acc;
                *(f32x4*)(hmeta + m * 1024 + n) = o;
                u32x2 w; w.x = pk2(o[0], o[1]); w.y = pk2(o[2], o[3]); *(u32x2*)(hb + (size_t)MR * 1024 + n) = w;
                float ss = (o[0] * o[0] + o[1] * o[1]) + (o[2] * o[2] + o[3] * o[3]); ss += __shfl_xor(ss, 16); ss += __shfl_xor(ss, 32);
                if (nq == 0) atomicAdd(rowss + (MODE == SK_OPROJ ? 1 : 2) * MALLOC + MR, ss);
            }
        } else if (MODE == SK_UP) {
            const int n0 = 16 * item; const f32x4 acc = skinny_tile<1024>(hb + (size_t)MBASE * 1024, (const bf16*)(ws + WS_WUP0), n0, lds, wid, lane);
            if (wid == 0) {
                const int n = n0 + 4 * nq; const float rs = pg8::rstd_of(rowss[1 * MALLOC + MR]);
                float v[4];
#pragma unroll
                for (int e = 0; e < 4; ++e) { const float t = fmaxf(acc[e] * rs, 0.f); v[e] = t * t; }
                u32x2 w; w.x = pk2(v[0], v[1]); w.y = pk2(v[2], v[3]); *(u32x2*)((bf16*)(ws + WS_ACT) + (size_t)MR * ACT_LD + n) = w;
            }
        } else {
            const int n0 = 1024 + 16 * item; const f32x4 acc = skinny_tile<1024>(hb + (size_t)MBASE * 1024, (const bf16*)(ws + WS_WIN), n0, lds, wid, lane);
            if (wid == 0) {
                const int n = n0 + 4 * nq - 1024; const float rs = pg8::rstd_of(rowss[2 * MALLOC + MR]);
                u32x2 w; w.x = pk2(acc[0] * rs, acc[1] * rs); w.y = pk2(acc[2] * rs, acc[3] * rs); *(u32x2*)((bf16*)(ws + WS_REC) + (size_t)MR * 1024 + n) = w;
            }
        }
    }
}

__device__ __forceinline__ void attn_half(const bf16x8 (&kf)[4], const bf16x8 (&vf)[2][2], const bf16x8 (&qf)[4], float& Prun, f32x16& o0, f32x16& o1, int key0, int qp, int hi) {
    f32x16 s;
#pragma unroll
    for (int r = 0; r < 16; ++r) s[r] = 0.f;
#pragma unroll
    for (int dc = 0; dc < 4; ++dc) s = __builtin_amdgcn_mfma_f32_32x32x16_bf16(kf[dc], qf[dc], s, 0, 0, 0);
    float kap[16];
#pragma unroll
    for (int r = 0; r < 16; ++r) {
        const int key = key0 + 16 * (r >> 3) + 8 * hi + (r & 7);
        const float kk = __builtin_amdgcn_rcpf(1.0f + __builtin_amdgcn_exp2f(s[r]));
        kap[r] = ((key < qp) && (key >= 0)) ? kk : 1.f;
    }
    float cc[16]; float t1 = 1.f, t0 = 1.f;
#pragma unroll
    for (int r = 15; r >= 8; --r) { cc[r] = t1; t1 *= kap[r]; }
#pragma unroll
    for (int r = 7; r >= 0; --r) { cc[r] = t0; t0 *= kap[r]; }
    const float G1 = t1, G0 = t0;
    const float G0o = __shfl_xor(G0, 32), G1o = __shfl_xor(G1, 32);
    const float pre1 = hi ? Prun : Prun * G1o;
    const float pre0 = hi ? Prun * G1 * G1o : Prun * G1o * G1 * G0o;
    Prun = Prun * G1 * G1o * G0 * G0o;
    float w[16];
#pragma unroll
    for (int r = 15; r >= 9; --r) w[r] = pre1 * (cc[r] - cc[r - 1]);
    w[8] = pre1 * (cc[8] - G1);
#pragma unroll
    for (int r = 7; r >= 1; --r) w[r] = pre0 * (cc[r] - cc[r - 1]);
    w[0] = pre0 * (cc[0] - G0);
    u32x4 p0, p1;
    p0.x = pg8::cvt_pk_bf16(w[0], w[1]); p0.y = pg8::cvt_pk_bf16(w[2], w[3]); p0.z = pg8::cvt_pk_bf16(w[4], w[5]); p0.w = pg8::cvt_pk_bf16(w[6], w[7]);
    p1.x = pg8::cvt_pk_bf16(w[8], w[9]); p1.y = pg8::cvt_pk_bf16(w[10], w[11]); p1.z = pg8::cvt_pk_bf16(w[12], w[13]); p1.w = pg8::cvt_pk_bf16(w[14], w[15]);
    const bf16x8 pf0 = __builtin_bit_cast(bf16x8, p0), pf1 = __builtin_bit_cast(bf16x8, p1);
    o0 = __builtin_amdgcn_mfma_f32_32x32x16_bf16(vf[0][0], pf0, o0, 0, 0, 0);
    o0 = __builtin_amdgcn_mfma_f32_32x32x16_bf16(vf[0][1], pf1, o0, 0, 0, 0);
    o1 = __builtin_amdgcn_mfma_f32_32x32x16_bf16(vf[1][0], pf0, o1, 0, 0, 0);
    o1 = __builtin_amdgcn_mfma_f32_32x32x16_bf16(vf[1][1], pf1, o1, 0, 0, 0);
}
__device__ __forceinline__ void attn_store(bf16* O, int row, int h, int hi, const f32x16& o0, const f32x16& o1) {
    bf16* op = O + (size_t)row * 1024 + h * 64 + 4 * hi;
#pragma unroll
    for (int g4 = 0; g4 < 4; ++g4) {
        u32x2 wa; wa.x = pg8::cvt_pk_bf16(o0[4 * g4], o0[4 * g4 + 1]); wa.y = pg8::cvt_pk_bf16(o0[4 * g4 + 2], o0[4 * g4 + 3]); *(u32x2*)(op + 8 * g4) = wa;
        u32x2 wb; wb.x = pg8::cvt_pk_bf16(o1[4 * g4], o1[4 * g4 + 1]); wb.y = pg8::cvt_pk_bf16(o1[4 * g4 + 2], o1[4 * g4 + 3]); *(u32x2*)(op + 32 + 8 * g4) = wb;
    }
}
__device__ __forceinline__ void attn_phase(const bf16* Q, const bf16* Kb, const bf16* Vt, bf16* O, int gw, int NGW, int lane) {
    const int q = lane & 31, hi = lane >> 5;
    const int pi = (q & 0x13) | ((q & 4) << 1) | ((q & 8) >> 1);
    for (int item = gw; item < 4096 + 16; item += NGW) {
        const bool metaq = item >= 4096;
        const int bh = metaq ? item - 4096 : (item & 63), j2 = metaq ? -1 : (item >> 6), b = bh >> 4, h = bh & 15;
        const size_t base = (size_t)bh * PP;
        const int q0 = 16 + 64 * j2;
        const int qpA = metaq ? q : q0 + q, qpB = metaq ? -1 : q0 + 32 + q;
        const bool validA = metaq ? (q < 16) : true, validB = !metaq;
        bf16x8 qfA[4], qfB[4];
#pragma unroll
        for (int dc = 0; dc < 4; ++dc) { qfA[dc] = *(const bf16x8*)(Q + (base + qpA) * 64 + 16 * dc + 8 * hi); qfB[dc] = *(const bf16x8*)(Q + (base + (qpB < 0 ? 0 : qpB)) * 64 + 16 * dc + 8 * hi); }
        f32x16 oA0, oA1, oB0, oB1;
#pragma unroll
        for (int r = 0; r < 16; ++r) { oA0[r] = 0.f; oA1[r] = 0.f; oB0[r] = 0.f; oB1[r] = 0.f; }
        float PrunA = validA ? 1.0f : 0.0f, PrunB = validB ? 1.0f : 0.0f;
        const int nunits = metaq ? 1 : 2 * j2 + 3;
        const int kfirst = metaq ? -16 : q0 + 32;
        bf16x8 kfn[4], vfn[2][2];
        {
            const int kk = kfirst + pi; const bf16* kp = Kb + (base + (kk < 0 ? 0 : kk)) * 64 + 8 * hi;
#pragma unroll
            for (int dc = 0; dc < 4; ++dc) kfn[dc] = *(const bf16x8*)(kp + 16 * dc);
#pragma unroll
            for (int db = 0; db < 2; ++db)
#pragma unroll
                for (int c = 0; c < 2; ++c) { const int col = kfirst + 16 * c + 8 * hi; vfn[db][c] = *(const bf16x8*)(Vt + ((size_t)(bh * 64 + db * 32 + q)) * PP + (col < 0 ? 0 : col)); }
        }
        for (int u = 0; u < nunits; ++u) {
            const int key0 = kfirst - 32 * u;
            bf16x8 kf[4], vf[2][2];
#pragma unroll
            for (int dc = 0; dc < 4; ++dc) kf[dc] = kfn[dc];
#pragma unroll
            for (int db = 0; db < 2; ++db)
#pragma unroll
                for (int c = 0; c < 2; ++c) vf[db][c] = vfn[db][c];
            if (u + 1 < nunits) {
                const int k1 = key0 - 32; const int kk = k1 + pi; const bf16* kp = Kb + (base + (kk < 0 ? 0 : kk)) * 64 + 8 * hi;
#pragma unroll
                for (int dc = 0; dc < 4; ++dc) kfn[dc] = *(const bf16x8*)(kp + 16 * dc);
#pragma unroll
                for (int db = 0; db < 2; ++db)
#pragma unroll
                    for (int c = 0; c < 2; ++c) { const int col = k1 + 16 * c + 8 * hi; vfn[db][c] = *(const bf16x8*)(Vt + ((size_t)(bh * 64 + db * 32 + q)) * PP + (col < 0 ? 0 : col)); }
            }
            attn_half(kf, vf, qfA, PrunA, oA0, oA1, key0, qpA, hi);
            attn_half(kf, vf, qfB, PrunB, oB0, oB1, key0, qpB, hi);
            if (__all((PrunA < 1e-37f) && (PrunB < 1e-37f))) break;
        }
        if (validA) attn_store(O, metaq ? MBASE + q : b * 4096 + qpA - 16, h, hi, oA0, oA1);
        if (validB) attn_store(O, b * 4096 + qpB - 16, h, hi, oB0, oB1);
    }
}
__device__ __forceinline__ float sigmoidf_(float x) { return __builtin_amdgcn_rcpf(1.0f + __builtin_amdgcn_exp2f(-1.4426950408889634f * x)); }
#define LDS_BAR() asm volatile("s_waitcnt lgkmcnt(0)\n\ts_barrier" ::: "memory")
__device__ __forceinline__ void scan_phase(const Args& a, unsigned char* lds, int G, int tid, int wid, int lane) {
    unsigned char* ws = a.ws;
    const bf16* rec = (const bf16*)(ws + WS_REC); bf16* HL = (bf16*)(ws + WS_HL); bf16* PC = (bf16*)(ws + WS_PC);
    float* carA = (float*)(ws + WS_CARA); float* carB = (float*)(ws + WS_CARB); float* hmend = (float*)(ws + WS_HMEND);
    const float* conv_w = a.in[7]; const float* conv_b = a.in[8]; const float* b_rg = a.in[10]; const float* b_ig = a.in[12]; const float* lam = a.in[13];
    float* u32f = (float*)lds;
    bf16* ubf = (bf16*)(lds + 33792);
    float* segs = (float*)(lds + 33792 + 17408);
    const int g = wid & 3, th = wid >> 2, q = lane & 31, hi = lane >> 5;
    const int tau = (q & 3) | (((q >> 3) & 3) << 2) | (((q >> 2) & 1) << 4);
    int cur_n = -1; float brg = 0.f, big = 0.f, cch = 0.f;
    bf16* wl = (bf16*)(lds + 33792 + 17408 + 4096 + 2560);
    float* cwl = (float*)(lds + 33792 + 17408 + 4096);
    const int ti = tid >> 3, cg8 = tid & 7;
    bf16x8 rn[8];
#define LOAD_REC(idq) do { const bool meta_ = (idq) >= 2048; const int n_ = (idq) & 7; int b_ = 0, c_ = 0; if (!meta_) { const int bc_ = (idq) >> 3; b_ = bc_ >> 6; c_ = bc_ & 63; } \
        _Pragma("unroll") for (int jt = 0; jt < 4; ++jt) { const int tt = (meta_ ? ti : 64 * c_ + ti) - 3 + jt; int row; if (meta_) row = (tt >= 0) ? MBASE + tt : -1; else row = (tt >= 0) ? b_ * 4096 + tt : MBASE + 16 + tt; \
            if (row >= 0) { rn[2 * jt] = *(const bf16x8*)(rec + (size_t)row * 1024 + 128 * n_ + 16 * cg8); rn[2 * jt + 1] = *(const bf16x8*)(rec + (size_t)row * 1024 + 128 * n_ + 16 * cg8 + 8); } \
            else { rn[2 * jt] = (bf16x8){0, 0, 0, 0, 0, 0, 0, 0}; rn[2 * jt + 1] = (bf16x8){0, 0, 0, 0, 0, 0, 0, 0}; } } } while (0)
    if ((int)blockIdx.x < 2056) LOAD_REC((int)blockIdx.x);
    for (int id = blockIdx.x; id < 2056; id += G) {
        const bool meta = id >= 2048; const int n = id & 7; int b = 0, c = 0; if (!meta) { const int bc = id >> 3; b = bc >> 6; c = bc & 63; }
        const int ch = 128 * n + 32 * g + q;
        if (n != cur_n) {
            for (int i = tid; i < 2 * 128 * 16; i += NTHREADS) { const int gsel = i >> 11, orow = (i >> 4) & 127, pc16 = i & 15;
                const bf16* src = (const bf16*)(ws + (gsel ? WS_WIG : WS_WRG)) + ((size_t)(n * 128 + orow)) * 128 + 8 * pc16;
                *(u32x4*)(wl + (gsel * 128 + orow) * 136 + 8 * pc16) = *(const u32x4*)src; }
            brg = b_rg[ch]; big = b_ig[ch]; cch = -8.0f * 1.4426950408889634f * log1pf(expf(-lam[ch])); cur_n = n;
            for (int i = tid; i < 640; i += NTHREADS) cwl[i] = (i < 512) ? conv_w[(i >> 7) * 1024 + 128 * n + (i & 127)] : conv_b[128 * n + (i - 512)];
            __syncthreads();
        }
        {
            float u[16];
#pragma unroll
            for (int e4 = 0; e4 < 4; ++e4) { const f32x4 bb = *(const f32x4*)(cwl + 512 + 16 * cg8 + 4 * e4); u[4 * e4] = bb[0]; u[4 * e4 + 1] = bb[1]; u[4 * e4 + 2] = bb[2]; u[4 * e4 + 3] = bb[3]; }
#pragma unroll
            for (int jt = 0; jt < 4; ++jt) {
                const bf16x8 r0 = rn[2 * jt], r1 = rn[2 * jt + 1];
#pragma unroll
                for (int e4 = 0; e4 < 4; ++e4) { const f32x4 wv = *(const f32x4*)(cwl + jt * 128 + 16 * cg8 + 4 * e4);
#pragma unroll
                    for (int e = 0; e < 4; ++e) { const int idx = 4 * e4 + e; const float rv = bf2f((unsigned short)(idx < 8 ? r0[idx] : r1[idx - 8])); u[idx] += rv * wv[e]; } }
            }
            if (id + G < 2056) LOAD_REC(id + G);
#pragma unroll
            for (int e4 = 0; e4 < 4; ++e4) { f32x4 v = {u[4 * e4], u[4 * e4 + 1], u[4 * e4 + 2], u[4 * e4 + 3]}; *(f32x4*)(u32f + ti * 132 + 16 * cg8 + 4 * e4) = v; }
            u32x4 w0, w1; w0.x = pk2(u[0], u[1]); w0.y = pk2(u[2], u[3]); w0.z = pk2(u[4], u[5]); w0.w = pk2(u[6], u[7]);
            w1.x = pk2(u[8], u[9]); w1.y = pk2(u[10], u[11]); w1.z = pk2(u[12], u[13]); w1.w = pk2(u[14], u[15]);
            *(u32x4*)(ubf + ti * 136 + 16 * cg8) = w0; *(u32x4*)(ubf + ti * 136 + 16 * cg8 + 8) = w1;
        }
        LDS_BAR();
        f32x16 Dr, Di;
#pragma unroll
        for (int r = 0; r < 16; ++r) { Dr[r] = 0.f; Di[r] = 0.f; }
#pragma unroll
        for (int ks = 0; ks < 8; ++ks) { const bf16x8 af = *(const bf16x8*)(ubf + (32 * th + tau) * 136 + 16 * ks + 8 * hi);
            const bf16x8 wrv = *(const bf16x8*)(wl + (32 * g + q) * 136 + 16 * ks + 8 * hi), wiv = *(const bf16x8*)(wl + (128 + 32 * g + q) * 136 + 16 * ks + 8 * hi);
            Dr = __builtin_amdgcn_mfma_f32_32x32x16_bf16(af, wrv, Dr, 0, 0, 0); Di = __builtin_amdgcn_mfma_f32_32x32x16_bf16(af, wiv, Di, 0, 0, 0); }
        float hl[16], pc[16]; float hcur = 0.f, P = 1.f;
#pragma unroll
        for (int r = 0; r < 16; ++r) {
            const int tok = 32 * th + 16 * hi + r; const float uval = u32f[tok * 132 + 32 * g + q];
            const float rr = sigmoidf_(Dr[r] + brg), ii = sigmoidf_(Di[r] + big);
            float av = __builtin_amdgcn_exp2f(cch * rr); float bt = __builtin_amdgcn_sqrtf((1.0f - av) * (1.0f + av)) * ii * uval;
            if (meta && tok >= 16) { av = 1.f; bt = 0.f; }
            hcur = av * hcur + bt; P *= av; hl[r] = hcur; pc[r] = P;
        }
        const int seg = 2 * th + hi;
        segs[(seg * 128 + 32 * g + q) * 2] = P; segs[(seg * 128 + 32 * g + q) * 2 + 1] = hcur;
        LDS_BAR();
        float hin = 0.f, Pin = 1.f;
#pragma unroll
        for (int s = 0; s < 3; ++s) if (s < seg) { const float A_ = segs[(s * 128 + 32 * g + q) * 2], B_ = segs[(s * 128 + 32 * g + q) * 2 + 1]; hin = A_ * hin + B_; Pin *= A_; }
#pragma unroll
        for (int r = 0; r < 16; ++r) { hl[r] += pc[r] * hin; pc[r] *= Pin; }
        if (!meta) {
            bf16* hlt = (bf16*)lds; bf16* pct = (bf16*)(lds + 17408);
#pragma unroll
            for (int r = 0; r < 16; ++r) { const int o_ = (32 * th + 16 * hi + r) * 136 + 32 * g + q; hlt[o_] = (bf16)f2bf(hl[r]); pct[o_] = (bf16)f2bf(pc[r]); }
            if (seg == 3) { carA[(size_t)(b * 64 + c) * 1024 + ch] = pc[15]; carB[(size_t)(b * 64 + c) * 1024 + ch] = hl[15]; }
            LDS_BAR();
#pragma unroll
            for (int k = 0; k < 2; ++k) { const int p_ = tid + NTHREADS * k, row = p_ >> 4, cpos = (p_ & 15) * 8; const size_t go = ((size_t)b * 4096 + 64 * c + row) * 1024 + 128 * n + cpos;
                *(u32x4*)(HL + go) = *(const u32x4*)(hlt + row * 136 + cpos); *(u32x4*)(PC + go) = *(const u32x4*)(pct + row * 136 + cpos); }
        } else if (seg == 3) hmend[ch] = hl[15];
        LDS_BAR();
    }
#undef LOAD_REC
}
__device__ __forceinline__ void fixup_phase(const Args& a, unsigned char* lds, int G, int tid, int wid, int lane) {
    unsigned char* ws = a.ws;
    const bf16* HL = (const bf16*)(ws + WS_HL); const bf16* PC = (const bf16*)(ws + WS_PC); const bf16* GT = (const bf16*)(ws + WS_GATE); bf16* Y = (bf16*)(ws + WS_Y);
    const float* carA = (const float*)(ws + WS_CARA); const float* carB = (const float*)(ws + WS_CARB); const float* hmend = (const float*)(ws + WS_HMEND);
    float* cA = (float*)lds; float* cB = cA + 64 * 64; float* hin_l = cB + 64 * 64;
    for (int item = blockIdx.x; item < 256; item += G) {
        const int b = item >> 6, s16 = (item >> 2) & 15, qtr = item & 3, ch0 = 64 * s16;
        for (int i = tid; i < 64 * 64; i += NTHREADS) { const int c = i >> 6, cc = i & 63; cA[i] = carA[(size_t)(b * 64 + c) * 1024 + ch0 + cc]; cB[i] = carB[(size_t)(b * 64 + c) * 1024 + ch0 + cc]; }
        __syncthreads();
        if (wid == 0) {
            float h = hmend[ch0 + lane];
#pragma unroll 16
            for (int c = 0; c < 16 * qtr; ++c) h = cA[c * 64 + lane] * h + cB[c * 64 + lane];
#pragma unroll
            for (int cc = 0; cc < 16; ++cc) { hin_l[cc * 64 + lane] = h; const int c = 16 * qtr + cc; h = cA[c * 64 + lane] * h + cB[c * 64 + lane]; }
        }
        __syncthreads();
        const int i = tid >> 3, l8 = tid & 7;
        for (int cc0 = 0; cc0 < 16; cc0 += 4) {
            bf16x8 h8[4], p8[4], g8[4];
#pragma unroll
            for (int k = 0; k < 4; ++k) { const size_t off = ((size_t)b * 4096 + 64 * (16 * qtr + cc0 + k) + i) * 1024 + ch0 + 8 * l8;
                h8[k] = *(const bf16x8*)(HL + off); p8[k] = *(const bf16x8*)(PC + off); g8[k] = *(const bf16x8*)(GT + off); }
#pragma unroll
            for (int k = 0; k < 4; ++k) { const size_t off = ((size_t)b * 4096 + 64 * (16 * qtr + cc0 + k) + i) * 1024 + ch0 + 8 * l8;
                float y[8];
#pragma unroll
                for (int e = 0; e < 8; ++e) y[e] = (bf2f((unsigned short)h8[k][e]) + bf2f((unsigned short)p8[k][e]) * hin_l[(cc0 + k) * 64 + 8 * l8 + e]) * bf2f((unsigned short)g8[k][e]);
                u32x4 w; w.x = pk2(y[0], y[1]); w.y = pk2(y[2], y[3]); w.z = pk2(y[4], y[5]); w.w = pk2(y[6], y[7]);
                *(u32x4*)(Y + off) = w; }
        }
        __syncthreads();
    }
}
__device__ __forceinline__ void scanfix_phase(const Args& a, unsigned char* lds, int G, int tid, int wid, int lane) {
    unsigned char* ws = a.ws;
    const bf16* rec = (const bf16*)(ws + WS_REC); bf16* HL = (bf16*)(ws + WS_HL); bf16* PC = (bf16*)(ws + WS_PC);
    float* carA = (float*)(ws + WS_CARA); float* carB = (float*)(ws + WS_CARB); float* hmend = (float*)(ws + WS_HMEND);
    const float* conv_w = a.in[7]; const float* conv_b = a.in[8]; const float* b_rg = a.in[10]; const float* b_ig = a.in[12]; const float* lam = a.in[13];
    float* u32f = (float*)lds;
    bf16* ubf = (bf16*)(lds + 33792);
    float* segs = (float*)(lds + 33792 + 17408);
    const int g = wid & 3, th = wid >> 2, q = lane & 31, hi = lane >> 5;
    const int tau = (q & 3) | (((q >> 3) & 3) << 2) | (((q >> 2) & 1) << 4);
    int cur_n = -1; float brg = 0.f, big = 0.f, cch = 0.f;
    bf16* wl = (bf16*)(lds + 33792 + 17408 + 4096 + 2560);
    float* cwl = (float*)(lds + 33792 + 17408 + 4096);
    const int ti = tid >> 3, cg8 = tid & 7;
    bf16x8 rn[8];
#define LOAD_REC(idq) do { const bool meta_ = (idq) >= 2048; const int n_ = (idq) & 7; int b_ = 0, c_ = 0; if (!meta_) { const int bc_ = (idq) >> 3; b_ = bc_ >> 6; c_ = bc_ & 63; } \
        _Pragma("unroll") for (int jt = 0; jt < 4; ++jt) { const int tt = (meta_ ? ti : 64 * c_ + ti) - 3 + jt; int row; if (meta_) row = (tt >= 0) ? MBASE + tt : -1; else row = (tt >= 0) ? b_ * 4096 + tt : MBASE + 16 + tt; \
            if (row >= 0) { rn[2 * jt] = *(const bf16x8*)(rec + (size_t)row * 1024 + 128 * n_ + 16 * cg8); rn[2 * jt + 1] = *(const bf16x8*)(rec + (size_t)row * 1024 + 128 * n_ + 16 * cg8 + 8); } \
            else { rn[2 * jt] = (bf16x8){0, 0, 0, 0, 0, 0, 0, 0}; rn[2 * jt + 1] = (bf16x8){0, 0, 0, 0, 0, 0, 0, 0}; } } } while (0)
    const int wn = blockIdx.x & 7, sg = (blockIdx.x >> 3) & 7, wb = blockIdx.x >> 6;
    const int NIT = (sg == 0) ? 9 : 8;
#define SID(k_) ((sg == 0) ? ((k_) == 0 ? 2048 + wn : ((((wb * 64 + 8 * sg + (k_) - 1)) << 3) | wn)) : ((((wb * 64 + 8 * sg + (k_))) << 3) | wn))
    float* carr = (float*)(lds + 127488);
    float* hin_l = (float*)(lds + 127488 + 2048);
    if (tid < 128) { carr[2 * tid] = 1.f; carr[2 * tid + 1] = 0.f; }
    LOAD_REC(SID(0));
    for (int kk = 0; kk < NIT; ++kk) {
        const int id = SID(kk);
        const bool meta = id >= 2048; const int n = id & 7; int b = 0, c = 0; if (!meta) { const int bc = id >> 3; b = bc >> 6; c = bc & 63; }
        const int ch = 128 * n + 32 * g + q;
        if (n != cur_n) {
            for (int i = tid; i < 2 * 128 * 16; i += NTHREADS) { const int gsel = i >> 11, orow = (i >> 4) & 127, pc16 = i & 15;
                const bf16* src = (const bf16*)(ws + (gsel ? WS_WIG : WS_WRG)) + ((size_t)(n * 128 + orow)) * 128 + 8 * pc16;
                *(u32x4*)(wl + (gsel * 128 + orow) * 136 + 8 * pc16) = *(const u32x4*)src; }
            brg = b_rg[ch]; big = b_ig[ch]; cch = -8.0f * 1.4426950408889634f * log1pf(expf(-lam[ch])); cur_n = n;
            for (int i = tid; i < 640; i += NTHREADS) cwl[i] = (i < 512) ? conv_w[(i >> 7) * 1024 + 128 * n + (i & 127)] : conv_b[128 * n + (i - 512)];
            __syncthreads();
        }
        {
            float u[16];
#pragma unroll
            for (int e4 = 0; e4 < 4; ++e4) { const f32x4 bb = *(const f32x4*)(cwl + 512 + 16 * cg8 + 4 * e4); u[4 * e4] = bb[0]; u[4 * e4 + 1] = bb[1]; u[4 * e4 + 2] = bb[2]; u[4 * e4 + 3] = bb[3]; }
#pragma unroll
            for (int jt = 0; jt < 4; ++jt) {
                const bf16x8 r0 = rn[2 * jt], r1 = rn[2 * jt + 1];
#pragma unroll
                for (int e4 = 0; e4 < 4; ++e4) { const f32x4 wv = *(const f32x4*)(cwl + jt * 128 + 16 * cg8 + 4 * e4);
#pragma unroll
                    for (int e = 0; e < 4; ++e) { const int idx = 4 * e4 + e; const float rv = bf2f((unsigned short)(idx < 8 ? r0[idx] : r1[idx - 8])); u[idx] += rv * wv[e]; } }
            }
            if (kk + 1 < NIT) LOAD_REC(SID(kk + 1));
#pragma unroll
            for (int e4 = 0; e4 < 4; ++e4) { f32x4 v = {u[4 * e4], u[4 * e4 + 1], u[4 * e4 + 2], u[4 * e4 + 3]}; *(f32x4*)(u32f + ti * 132 + 16 * cg8 + 4 * e4) = v; }
            u32x4 w0, w1; w0.x = pk2(u[0], u[1]); w0.y = pk2(u[2], u[3]); w0.z = pk2(u[4], u[5]); w0.w = pk2(u[6], u[7]);
            w1.x = pk2(u[8], u[9]); w1.y = pk2(u[10], u[11]); w1.z = pk2(u[12], u[13]); w1.w = pk2(u[14], u[15]);
            *(u32x4*)(ubf + ti * 136 + 16 * cg8) = w0; *(u32x4*)(ubf + ti * 136 + 16 * cg8 + 8) = w1;
        }
        LDS_BAR();
        f32x16 Dr, Di;
#pragma unroll
        for (int r = 0; r < 16; ++r) { Dr[r] = 0.f; Di[r] = 0.f; }
#pragma unroll
        for (int ks = 0; ks < 8; ++ks) { const bf16x8 af = *(const bf16x8*)(ubf + (32 * th + tau) * 136 + 16 * ks + 8 * hi);
            const bf16x8 wrv = *(const bf16x8*)(wl + (32 * g + q) * 136 + 16 * ks + 8 * hi), wiv = *(const bf16x8*)(wl + (128 + 32 * g + q) * 136 + 16 * ks + 8 * hi);
            Dr = __builtin_amdgcn_mfma_f32_32x32x16_bf16(af, wrv, Dr, 0, 0, 0); Di = __builtin_amdgcn_mfma_f32_32x32x16_bf16(af, wiv, Di, 0, 0, 0); }
        float hl[16], pc[16]; float hcur = 0.f, P = 1.f;
#pragma unroll
        for (int r = 0; r < 16; ++r) {
            const int tok = 32 * th + 16 * hi + r; const float uval = u32f[tok * 132 + 32 * g + q];
            const float rr = sigmoidf_(Dr[r] + brg), ii = sigmoidf_(Di[r] + big);
            float av = __builtin_amdgcn_exp2f(cch * rr); float bt = __builtin_amdgcn_sqrtf((1.0f - av) * (1.0f + av)) * ii * uval;
            if (meta && tok >= 16) { av = 1.f; bt = 0.f; }
            hcur = av * hcur + bt; P *= av; hl[r] = hcur; pc[r] = P;
        }
        const int seg = 2 * th + hi;
        segs[(seg * 128 + 32 * g + q) * 2] = P; segs[(seg * 128 + 32 * g + q) * 2 + 1] = hcur;
        LDS_BAR();
        const float* cin = carr + (kk & 1) * 256;
        float hin = cin[2 * (32 * g + q) + 1], Pin = cin[2 * (32 * g + q)];
#pragma unroll
        for (int s = 0; s < 3; ++s) if (s < seg) { const float A_ = segs[(s * 128 + 32 * g + q) * 2], B_ = segs[(s * 128 + 32 * g + q) * 2 + 1]; hin = A_ * hin + B_; Pin *= A_; }
#pragma unroll
        for (int r = 0; r < 16; ++r) { hl[r] += pc[r] * hin; pc[r] *= Pin; }
        if (!meta) {
            bf16* hlt = (bf16*)lds; bf16* pct = (bf16*)(lds + 17408);
#pragma unroll
            for (int r = 0; r < 16; ++r) { const int o_ = (32 * th + 16 * hi + r) * 136 + 32 * g + q; hlt[o_] = (bf16)f2bf(hl[r]); pct[o_] = (bf16)f2bf(pc[r]); }
            LDS_BAR();
#pragma unroll
            for (int k = 0; k < 2; ++k) { const int p_ = tid + NTHREADS * k, row = p_ >> 4, cpos = (p_ & 15) * 8; const size_t go = ((size_t)b * 4096 + 64 * c + row) * 1024 + 128 * n + cpos;
                *(u32x4*)(HL + go) = *(const u32x4*)(hlt + row * 136 + cpos); *(u32x4*)(PC + go) = *(const u32x4*)(pct + row * 136 + cpos); }
        }
        if (seg == 3) { float* cout = carr + ((kk + 1) & 1) * 256; cout[2 * (32 * g + q)] = pc[15]; cout[2 * (32 * g + q) + 1] = hl[15]; }
        LDS_BAR();
    }
#undef LOAD_REC
#undef SID
    float* agg = (float*)(ws + WS_CARA);
    unsigned* sflag = (unsigned*)(ws + WS_SFLAG);
    const int strm = wb * 8 + wn;
    {
        const float* cfin = carr + (NIT & 1) * 256;
        if (tid < 256) __hip_atomic_store(agg + ((size_t)(strm * 8 + sg)) * 256 + tid, cfin[tid], __ATOMIC_RELAXED, __HIP_MEMORY_SCOPE_AGENT);
    }
    asm volatile("s_waitcnt vmcnt(0)" ::: "memory");
    __syncthreads();
    if (tid == 0) __hip_atomic_store(sflag + strm * 8 + sg, 1u, __ATOMIC_RELAXED, __HIP_MEMORY_SCOPE_AGENT);
    if (tid < sg) { unsigned spins = 0; while (__hip_atomic_load(sflag + strm * 8 + tid, __ATOMIC_RELAXED, __HIP_MEMORY_SCOPE_AGENT) != 1u) { __builtin_amdgcn_s_sleep(2); if (++spins > (1u << 22)) break; } }
    __syncthreads();
    if (tid < 128) {
        float Av[7], Bv[7];
#pragma unroll
        for (int t = 0; t < 7; ++t) { Av[t] = 1.f; Bv[t] = 0.f; if (t < sg) { Av[t] = __hip_atomic_load(agg + ((size_t)(strm * 8 + t)) * 256 + 2 * tid, __ATOMIC_RELAXED, __HIP_MEMORY_SCOPE_AGENT);
            Bv[t] = __hip_atomic_load(agg + ((size_t)(strm * 8 + t)) * 256 + 2 * tid + 1, __ATOMIC_RELAXED, __HIP_MEMORY_SCOPE_AGENT); } }
        float h = 0.f;
#pragma unroll
        for (int t = 0; t < 7; ++t) if (t < sg) h = Av[t] * h + Bv[t];
        hin_l[tid] = h;
    }
    __syncthreads();
    {
        const bf16* GT = (const bf16*)(ws + WS_GATE); bf16* Y = (bf16*)(ws + WS_Y);
        for (int cc0 = 0; cc0 < 8; cc0 += 2) {
            u32x4 hv[2][2], pv[2][2], gv[2][2];
#pragma unroll
            for (int j = 0; j < 2; ++j)
#pragma unroll
                for (int k = 0; k < 2; ++k) { const int p_ = tid + NTHREADS * k, row = p_ >> 4, cpos = (p_ & 15) * 8;
                    const size_t go = ((size_t)wb * 4096 + 64 * (8 * sg + cc0 + j) + row) * 1024 + 128 * wn + cpos;
                    hv[j][k] = *(const u32x4*)(HL + go); pv[j][k] = *(const u32x4*)(PC + go); gv[j][k] = *(const u32x4*)(GT + go); }
#pragma unroll
            for (int j = 0; j < 2; ++j)
#pragma unroll
                for (int k = 0; k < 2; ++k) { const int p_ = tid + NTHREADS * k, row = p_ >> 4, cpos = (p_ & 15) * 8;
                    const size_t go = ((size_t)wb * 4096 + 64 * (8 * sg + cc0 + j) + row) * 1024 + 128 * wn + cpos;
                    u32x4 yo;
#pragma unroll
                    for (int e = 0; e < 4; ++e) { const float h0 = hin_l[cpos + 2 * e], h1 = hin_l[cpos + 2 * e + 1];
                        yo[e] = pk2((pg8::bflo(hv[j][k][e]) + pg8::bflo(pv[j][k][e]) * h0) * pg8::bflo(gv[j][k][e]), (pg8::bfhi(hv[j][k][e]) + pg8::bfhi(pv[j][k][e]) * h1) * pg8::bfhi(gv[j][k][e])); }
                    *(u32x4*)(Y + go) = yo; }
        }
    }
}
__device__ __forceinline__ void final_norm(const Args& a, int gw, int NGW, int lane) {
    const float* rowss4 = (const float*)(a.ws + WS_ROWSS) + 4 * MALLOC; const float* gfin = a.in[17]; const bf16* hb = (const bf16*)(a.ws + WS_HB);
    const f32x4 g0 = ((const f32x4*)gfin)[2 * lane], g1 = ((const f32x4*)gfin)[2 * lane + 1], g2 = ((const f32x4*)gfin)[128 + 2 * lane], g3 = ((const f32x4*)gfin)[128 + 2 * lane + 1];
    for (int m = gw; m < NREAL; m += NGW) {
        const float rs = pg8::rstd_of(rowss4[m]); const u32x4* hp = (const u32x4*)(hb + (size_t)m * 1024) + lane; f32x4* p = (f32x4*)(a.out + (size_t)m * 1024);
        const u32x4 v0 = hp[0], v1 = hp[64];
        f32x4 o;
        o = (f32x4){pg8::bflo(v0.x), pg8::bfhi(v0.x), pg8::bflo(v0.y), pg8::bfhi(v0.y)}; p[2 * lane] = o * rs * g0;
        o = (f32x4){pg8::bflo(v0.z), pg8::bfhi(v0.z), pg8::bflo(v0.w), pg8::bfhi(v0.w)}; p[2 * lane + 1] = o * rs * g1;
        o = (f32x4){pg8::bflo(v1.x), pg8::bfhi(v1.x), pg8::bflo(v1.y), pg8::bfhi(v1.y)}; p[128 + 2 * lane] = o * rs * g2;
        o = (f32x4){pg8::bflo(v1.z), pg8::bfhi(v1.z), pg8::bflo(v1.w), pg8::bfhi(v1.w)}; p[128 + 2 * lane + 1] = o * rs * g3;
    }
}

#define XB_TMO      128
#define XB_XCNT(j)  (256  + 64 * (j))
#define XB_XSUB(j)  (1280 + 64 * (j))
#define XB_XGEN(j)  (2304 + 64 * (j))
#define XB_TOP      3328
#define XB_TOPGEN   3392
#define XCD_BAR_WORDS 3456
#define XB_SPIN_CAP (1u << 18)

__device__ __forceinline__ unsigned xb_ld(unsigned* p)              { return __hip_atomic_load(p, __ATOMIC_RELAXED, __HIP_MEMORY_SCOPE_AGENT); }
__device__ __forceinline__ unsigned xb_add(unsigned* p, unsigned v) { return __hip_atomic_fetch_add(p, v, __ATOMIC_RELAXED, __HIP_MEMORY_SCOPE_AGENT); }
__device__ __forceinline__ unsigned xb_xcc_id() { return (unsigned)__builtin_amdgcn_s_getreg((3 << 11) | 20) & 0xFu; }
#define XB_SPIN(cond, bar) do { unsigned _sp = 0; while (cond) { __builtin_amdgcn_s_sleep(1); \
    if ((++_sp & 255u) == 0u) { if (xb_ld(&(bar)[XB_TMO])) break; if (_sp > XB_SPIN_CAP) { atomicAdd(&(bar)[XB_TMO], 1u); break; } } } } while (0)

struct XcdBarrier {
    unsigned* bar; unsigned x;
    volatile LAS unsigned* st;
};

__device__ __forceinline__ XcdBarrier xcd_barrier_post(unsigned* bar, volatile LAS unsigned* st) {
    XcdBarrier b; b.bar = bar; b.x = xb_xcc_id(); b.st = st;
    if (threadIdx.x == 0) (void)xb_add(&bar[XB_XCNT(b.x)], 1u);
    return b;
}
__device__ __forceinline__ void xcd_barrier_complete(unsigned* bar, unsigned x, unsigned& nloc, unsigned& nx) {
    const unsigned G = gridDim.x * gridDim.y * gridDim.z;
    unsigned sum, cnt, mine, sp = 0u;
    for (;;) {
        sum = 0u; cnt = 0u; mine = 0u;
#pragma unroll
        for (unsigned j = 0; j < 16; ++j) { const unsigned c = xb_ld(&bar[XB_XCNT(j)]); sum += c; cnt += (c > 0u) ? 1u : 0u; mine = (j == x) ? c : mine; }
        if (sum == G) break;
        __builtin_amdgcn_s_sleep(1);
        if ((++sp & 255u) == 0u) { if (xb_ld(&bar[XB_TMO])) break; if (sp > XB_SPIN_CAP) { atomicAdd(&bar[XB_TMO], 1u); break; } }
    }
    nloc = mine > 0u ? mine : 1u; nx = cnt > 0u ? cnt : 1u;
}

__device__ __forceinline__ void xcd_barrier(const XcdBarrier& b) {
    asm volatile("s_waitcnt vmcnt(0)" ::: "memory");
    __syncthreads();
    if (threadIdx.x == 0) {
        unsigned* bar = b.bar;
        __builtin_amdgcn_s_waitcnt(0);
        unsigned nloc = b.st[0], nx = b.st[1];
        if (nloc == 0u) { xcd_barrier_complete(bar, b.x, nloc, nx); b.st[0] = nloc; b.st[1] = nx; }
        const unsigned old = xb_add(&bar[XB_XSUB(b.x)], 1u);
        const unsigned gen = old / nloc;
        if (old + 1u == (gen + 1u) * nloc) {
            __builtin_amdgcn_fence(__ATOMIC_RELEASE, "agent");
            asm volatile("s_waitcnt vmcnt(0)" ::: "memory");
            const unsigned og = xb_add(&bar[XB_TOP], 1u);
            const unsigned tg = og / nx;
            if (og + 1u == (tg + 1u) * nx) xb_add(&bar[XB_TOPGEN], 1u);
            else XB_SPIN(xb_ld(&bar[XB_TOPGEN]) == tg, bar);
            __builtin_amdgcn_fence(__ATOMIC_ACQUIRE, "agent");
            xb_add(&bar[XB_XGEN(b.x)], 1u);
            asm volatile("s_waitcnt vmcnt(0)" ::: "memory");
        } else {
            XB_SPIN(xb_ld(&bar[XB_XGEN(b.x)]) == gen, bar);
            __builtin_amdgcn_fence(__ATOMIC_ACQUIRE, "agent");
            asm volatile("s_waitcnt vmcnt(0)" ::: "memory");
        }
    }
    __syncthreads();
}

__global__ void __launch_bounds__(NTHREADS, 2) fwd_kernel(Args args) {
    extern __shared__ __attribute__((aligned(16))) unsigned char lds[];
    cg::grid_group grid = cg::this_grid();
    const int tid = threadIdx.x, lane = tid & 63, wid = __builtin_amdgcn_readfirstlane(tid >> 6);
    const int G = gridDim.x, gw = blockIdx.x * NWAVES + wid, NGW = G * NWAVES;
    unsigned char* ws = args.ws; float* rowss = (float*)(ws + WS_ROWSS); bf16* hb = (bf16*)(ws + WS_HB);
    const int lo = args.ph_lo, hi = args.ph_hi;
#define IN(k) (lo <= (k) && (k) < hi)
#ifndef PROBE_MASK
#define PROBE_MASK 0
#endif
#define REPS(k) (((PROBE_MASK >> (k)) & 1) ? 2 : 1)
#define SEAM(k) do { if (IN(k) && IN((k) + 1)) xcd_barrier(xb); } while (0)
    unsigned* barw = (unsigned*)(ws + WS_BAR); volatile LAS unsigned* st = (volatile LAS unsigned*)((LAS unsigned char*)lds + 131072 + 32);
    if (tid < 2) st[tid] = 0u;
    __syncthreads();
    if (lo < 0) grid.sync();
    XcdBarrier xb = xcd_barrier_post(barw, st);
    PG8_LAS unsigned char* ldsp = (PG8_LAS unsigned char*)lds;
    PG8_LAS float* rstl = (PG8_LAS float*)((PG8_LAS unsigned char*)lds + 131072 + 1024);
#define FILL_RST(ROWSS) int nrst_ = 0; { pg8::Unit uu_; while (nrst_ < 12 && S.next(nrst_, uu_)) { if (tid < 256) rstl[nrst_ * 256 + tid] = pg8::rstd_of((ROWSS)[uu_.pm * 256 + tid]); ++nrst_; } } __syncthreads()
    if (IN(0)) for (int rep_ = 0; rep_ < REPS(0); ++rep_) { prologue(args, lds, gw, NGW, wid, lane); } SEAM(0);
    if (IN(1)) {
        skinny_phase<SK_QKV>(args, lds, G, wid, lane);
#if defined(PROBE_SKINNY)
        skinny_phase<SK_QKV>(args, lds, G, wid, lane);
#endif
        pg8::Gemm g{hb, (const bf16*)(ws + WS_WQKV), NREAL, 3072, 1024, 1024, 1024}; pg8::StaticOrder S; S.init(NREAL, 3072, G, (int)blockIdx.x);
        FILL_RST(rowss);
        pg8::EpiQKV E{(bf16*)(ws + WS_Q), (bf16*)(ws + WS_K), (bf16*)(ws + WS_VT), rowss, QSCALE, rstl, nrst_, (PG8_LAS unsigned char*)lds + 131072 + 1024 + 12288};
        pg8::gemm_phase<pg8::EpiQKV, pg8::StaticOrder, true, true>(ldsp, g, S, E);
    } SEAM(1);
    if (IN(2)) for (int rep_ = 0; rep_ < REPS(2); ++rep_) { attn_phase((const bf16*)(ws + WS_Q), (const bf16*)(ws + WS_K), (const bf16*)(ws + WS_VT), (bf16*)(ws + WS_O), gw, NGW, lane); } SEAM(2);
    if (IN(3)) {
        skinny_phase<SK_OPROJ>(args, lds, G, wid, lane);
        pg8::Gemm g{(const bf16*)(ws + WS_O), (const bf16*)(ws + WS_WO), NREAL, 1024, 1024, 1024, 1024}; pg8::StaticOrder S; S.init(NREAL, 1024, G, (int)blockIdx.x);
        pg8::EpiResid E{hb, rowss + 1 * MALLOC};
        pg8::gemm_phase<pg8::EpiResid, pg8::StaticOrder, true, true>(ldsp, g, S, E);
    } SEAM(3);
    if (IN(4)) {
        skinny_phase<SK_UP>(args, lds, G, wid, lane);
#if defined(PROBE_SKINNY)
        skinny_phase<SK_UP>(args, lds, G, wid, lane);
#endif
        pg8::Gemm g{hb, (const bf16*)(ws + WS_WUP0), NREAL, 4096, 1024, 1024, 1024}; pg8::StaticOrder S; S.init(NREAL, 4096, G, (int)blockIdx.x);
        FILL_RST(rowss + 1 * MALLOC);
        pg8::EpiUp E{(bf16*)(ws + WS_ACT), rowss + 1 * MALLOC, rstl, nrst_};
        pg8::gemm_phase<pg8::EpiUp, pg8::StaticOrder, true, true>(ldsp, g, S, E);
    }
#if defined(PROBE_DUP4)
    if (IN(4)) {
        pg8::Gemm g{hb, (const bf16*)(ws + WS_WUP0), NREAL, 4096, 1024, 1024, 1024}; pg8::StaticOrder S; S.init(NREAL, 4096, G, (int)blockIdx.x);
        pg8::EpiUp E{(bf16*)(ws + WS_ACT), rowss + 1 * MALLOC};
        pg8::gemm_phase<pg8::EpiUp, pg8::StaticOrder, true, true>(ldsp, g, S, E);
    }
#endif
#if defined(PROBE_DUP1)
    if (IN(4)) {
        pg8::Gemm g{hb, (const bf16*)(ws + WS_WQKV), NREAL, 3072, 1024, 1024, 1024}; pg8::StaticOrder S; S.init(NREAL, 3072, G, (int)blockIdx.x);
        pg8::EpiQKV E{(bf16*)(ws + WS_Y), (bf16*)(ws + WS_Y), (bf16*)(ws + WS_Y), rowss, QSCALE};
        pg8::gemm_phase<pg8::EpiQKV, pg8::StaticOrder, true, true>(ldsp, g, S, E);
    }
#endif
    SEAM(4);
    if (IN(5)) {
        skinny_phase<SK_DOWN>(args, lds, G, wid, lane);
        pg8::Gemm g{(const bf16*)(ws + WS_ACT), (const bf16*)(ws + WS_WDN0), NREAL, 1024, 4096, ACT_LD, ACT_LD}; pg8::StaticOrder S; S.init(NREAL, 1024, G, (int)blockIdx.x);
        pg8::EpiResid E{hb, rowss + 2 * MALLOC};
        pg8::gemm_phase<pg8::EpiResid, pg8::StaticOrder, true, true>(ldsp, g, S, E);
    }
#if defined(PROBE_K4096)
    if (IN(5)) {
        pg8::Gemm g{(const bf16*)(ws + WS_ACT), (const bf16*)(ws + WS_WDN0), NREAL, 1024, 4096, ACT_LD, ACT_LD}; pg8::StaticOrder S; S.init(NREAL, 1024, G, (int)blockIdx.x);
        pg8::EpiNull E{(float*)(ws + WS_Y)};
        pg8::gemm_phase<pg8::EpiNull, pg8::StaticOrder, true, true>(ldsp, g, S, E);
    }
#endif
#if defined(PROBE_K1024)
    if (IN(5)) {
        pg8::Gemm g{hb, (const bf16*)(ws + WS_WO), NREAL, 1024, 1024, 1024, 1024}; pg8::StaticOrder S; S.init(NREAL, 1024, G, (int)blockIdx.x);
        pg8::EpiNull E{(float*)(ws + WS_Y)};
        pg8::gemm_phase<pg8::EpiNull, pg8::StaticOrder, true, true>(ldsp, g, S, E);
    }
#endif
#if defined(PROBE_UPNULL)
    if (IN(5)) {
        pg8::Gemm g{hb, (const bf16*)(ws + WS_WUP0), NREAL, 4096, 1024, 1024, 1024}; pg8::StaticOrder S; S.init(NREAL, 4096, G, (int)blockIdx.x);
        pg8::EpiNull E{(float*)(ws + WS_Y)};
        pg8::gemm_phase<pg8::EpiNull, pg8::StaticOrder, true, true>(ldsp, g, S, E);
    }
#endif
    SEAM(5);
    if (IN(6)) {
        skinny_phase<SK_WIN>(args, lds, G, wid, lane);
#if defined(PROBE_SKINNY)
        skinny_phase<SK_WIN>(args, lds, G, wid, lane);
#endif
        pg8::Gemm g{hb, (const bf16*)(ws + WS_WIN), NREAL, 2048, 1024, 1024, 1024}; pg8::StaticOrder S; S.init(NREAL, 2048, G, (int)blockIdx.x);
        FILL_RST(rowss + 2 * MALLOC);
        pg8::EpiWin E{(bf16*)(ws + WS_GATE), (bf16*)(ws + WS_REC), rowss + 2 * MALLOC, rstl, nrst_};
        pg8::gemm_phase<pg8::EpiWin, pg8::StaticOrder, true, true>(ldsp, g, S, E);
    } SEAM(6);
    if (IN(7)) { scanfix_phase(args, lds, G, tid, wid, lane); }
    SEAM(8);
    if (IN(9)) {
        pg8::Gemm g{(const bf16*)(ws + WS_Y), (const bf16*)(ws + WS_WOUT), NREAL, 1024, 1024, 1024, 1024}; pg8::StaticOrder S; S.init(NREAL, 1024, G, (int)blockIdx.x);
        pg8::EpiResid E{hb, rowss + 3 * MALLOC};
        pg8::gemm_phase<pg8::EpiResid, pg8::StaticOrder, true, true>(ldsp, g, S, E);
    } SEAM(9);
    if (IN(10)) {
        pg8::Gemm g{hb, (const bf16*)(ws + WS_WUP1), NREAL, 4096, 1024, 1024, 1024}; pg8::StaticOrder S; S.init(NREAL, 4096, G, (int)blockIdx.x);
        FILL_RST(rowss + 3 * MALLOC);
        pg8::EpiUp E{(bf16*)(ws + WS_ACT), rowss + 3 * MALLOC, rstl, nrst_};
        pg8::gemm_phase<pg8::EpiUp, pg8::StaticOrder, true, true>(ldsp, g, S, E);
    } SEAM(10);
    if (IN(11)) {
        pg8::Gemm g{(const bf16*)(ws + WS_ACT), (const bf16*)(ws + WS_WDN1), NREAL, 1024, 4096, ACT_LD, ACT_LD}; pg8::StaticOrder S; S.init(NREAL, 1024, G, (int)blockIdx.x);
        if (G == 256) {
            pg8::EpiFinal E{hb, rowss + 4 * MALLOC, args.out, args.in[17], (unsigned*)(ws + WS_PCNT)};
            pg8::gemm_phase<pg8::EpiFinal, pg8::StaticOrder, false, true>(ldsp, g, S, E);
        } else {
            pg8::EpiResid E{hb, rowss + 4 * MALLOC};
            pg8::gemm_phase<pg8::EpiResid, pg8::StaticOrder, true, true>(ldsp, g, S, E);
        }
    }
    if (G != 256) { SEAM(11); if (IN(12)) { final_norm(args, gw, NGW, lane); } }
#undef IN
#undef SEAM
}

#ifndef N_LAUNCH_MODE
#define N_LAUNCH_MODE 1
#endif
extern "C" void kernel_launch(void* const* d_in, const int* in_sizes, int n_in, void* d_out, int out_size, void* d_ws, size_t ws_size, hipStream_t stream) {
    static int grid = 0;
    if (grid == 0) {
        if (n_in != 18 || out_size != NREAL * DM || ws_size < WS_END) { fprintf(stderr, "kernel_launch: unexpected shapes (n_in %d out %d ws %zu)\n", n_in, out_size, ws_size); grid = -1; return; }
        int dev = 0, cus = 0, per_cu = 0;
        hipGetDevice(&dev); hipDeviceGetAttribute(&cus, hipDeviceAttributeMultiprocessorCount, dev);
        if (hipFuncSetAttribute((const void*)fwd_kernel, hipFuncAttributeMaxDynamicSharedMemorySize, LDS_BYTES) != hipSuccess) { fprintf(stderr, "kernel_launch: hipFuncSetAttribute failed\n"); grid = -1; return; }
        if (hipOccupancyMaxActiveBlocksPerMultiprocessor(&per_cu, (const void*)fwd_kernel, NTHREADS, LDS_BYTES) != hipSuccess || per_cu < 1) { fprintf(stderr, "kernel_launch: occupancy query gave %d\n", per_cu); per_cu = 1; }
        (void)hipGetLastError();
        grid = cus;
        if (grid != 256) { fprintf(stderr, "kernel_launch: %d CUs: the fused scan phase is laid out for 256 workgroups; nothing launched\n", grid); grid = -1; return; }
        if (grid < 96) { fprintf(stderr, "kernel_launch: %d CUs: the per-workgroup rstd table holds 12 units; nothing launched\n", grid); grid = -1; return; }
        fprintf(stderr, "kernel_launch: grid %d (cus %d, per_cu %d)\n", grid, cus, per_cu);
    }
    if (grid < 0) return;
    Args a{};
    for (int i = 0; i < 18; ++i) a.in[i] = (const float*)d_in[i];
    a.out = (float*)d_out; a.ws = (unsigned char*)d_ws;
    if (N_LAUNCH_MODE == 1) {
        a.ph_lo = 0; a.ph_hi = 13;
        if (hipMemsetAsync((unsigned char*)d_ws + WS_BAR, 0, XCD_BAR_WORDS * 4, stream) != hipSuccess) { fprintf(stderr, "kernel_launch: memset of the barrier words failed\n"); return; }
        void* kargs[] = {&a};
        hipError_t e = hipLaunchCooperativeKernel((const void*)fwd_kernel, dim3(grid), dim3(NTHREADS), kargs, LDS_BYTES, stream);
        if (e != hipSuccess) fprintf(stderr, "cooperative launch failed: %s (grid %d)\n", hipGetErrorString(e), grid);
    } else {
        for (int p = 0; p < 13; ++p) { a.ph_lo = p; a.ph_hi = p + 1; hipLaunchKernelGGL(fwd_kernel, dim3(grid), dim3(NTHREADS), LDS_BYTES, stream, a); }
    }
}
```

```cpp
#include <hip/hip_runtime.h>
#include <hip/hip_cooperative_groups.h>
#include <cstdio>
#include <cstdint>
namespace cg = cooperative_groups;
namespace pg8 {
#define PG8_LAS __attribute__((address_space(3)))
typedef unsigned short bf16_t;
typedef short bf16x8 __attribute__((ext_vector_type(8)));
typedef float f32x4 __attribute__((ext_vector_type(4)));
typedef unsigned u32x4 __attribute__((ext_vector_type(4)));
constexpr int BM = 256, BK = 64, HALF = 128, HTB = HALF * BK * 2  , STAGE_BYTES = 8 * HTB, NXCD = 8, WGM = 8;

__host__ __device__ __forceinline__ int lds_byte(int r, int c) { const int st = (r >> 4) * 2 + (c >> 5), rr = r & 15, cc = c & 31, ob = rr * 64 + cc * 2; return st * 1024 + (ob ^ (((ob >> 9) & 1) << 5)); }
__host__ __device__ __forceinline__ void stage_rc(int b, int& R, int& C) { const int st = b / 1024, sb = b % 1024, swz = sb ^ (((sb >> 9) & 1) << 5); R = (st >> 1) * 16 + swz / 64; C = (st & 1) * 32 + (swz % 64) / 2; }
__host__ __device__ __forceinline__ int perm32(int rho) { const int n = rho >> 4, i = rho & 15; return 8 * (i >> 2) + 4 * n + (i & 3); }

struct Unit { int pm, pn; };
struct Gemm { const bf16_t* A; const bf16_t* Bt; int M, N, K, lda, ldb; };

struct StaticOrder {
    int nM, nN, nwg, G, c;
    __host__ __device__ void init(int M, int N, int G_, int c_) { nM = M / BM; nN = N / BM; nwg = nM * nN; G = G_; c = c_; }
    __host__ __device__ bool next(int i, Unit& u) const {
        const long L = (long)i * G + c; if (L >= nwg) return false;
        int wgid = (int)L; { const int q = nwg / NXCD, r = nwg % NXCD, xcd = wgid % NXCD, off = wgid / NXCD; wgid = (xcd < r ? xcd * (q + 1) : r * (q + 1) + (xcd - r) * q) + off; }
        const int nig = WGM * nN, gid = wgid / nig, fm = gid * WGM, gsz = (nM - fm) < WGM ? (nM - fm) : WGM;
        u.pm = fm + ((wgid % nig) % gsz); u.pn = (wgid % nig) / gsz; return true;
    }
    __device__ __forceinline__ void a_ready(const Unit&) const {}
    __device__ __forceinline__ void done(const Unit&) const {}
};

__device__ __forceinline__ unsigned cvt_pk_bf16(float lo, float hi) { unsigned r; asm volatile("v_cvt_pk_bf16_f32 %0, %1, %2" : "=v"(r) : "v"(lo), "v"(hi)); return r; }
typedef float f32x2 __attribute__((ext_vector_type(2)));
typedef unsigned u32x2 __attribute__((ext_vector_type(2)));
__device__ __forceinline__ void st16_wt(void* p, u32x4 v) { asm volatile("global_store_dwordx4 %0, %1, off sc1\n\ts_nop 1" :: "v"(p), "v"(v) : "memory"); }
constexpr int PP = 4128;
constexpr float EPSN = 1e-6f;
constexpr int ACT_LD = 4160;
__device__ __forceinline__ float rstd_of(float ss) { return rsqrtf(ss * (1.0f / 1024.0f) + EPSN); }
struct EpiQKV {
    static constexpr bool PERM = true, AFTER_DRAIN = false;
    bf16_t* Q; bf16_t* Kb; bf16_t* Vt; const float* rowss; float qscale; const PG8_LAS float* rst; int nrst; PG8_LAS unsigned char* tl; mutable int ui = 0;
    __device__ __forceinline__ void operator()(const f32x4 (&acc)[2][2][4][2], const Unit& u, int wr, int wc, int fr, int fq) const {
        const int colt = u.pn * BM; const int which = colt >> 10; const int cbase = (colt & 1023) + wc * 32 + 8 * fq;
#pragma unroll
        for (int ai = 0; ai < 2; ++ai)
#pragma unroll
            for (int m = 0; m < 4; ++m) {
                const int row = u.pm * BM + ai * HALF + wr * 64 + m * 16 + fr;
                const int b = row >> 12, pos = (row & 4095) + 16;
                float rs = rst[ui * 256 + ai * HALF + wr * 64 + m * 16 + fr]; if (which == 0) rs *= qscale;
#pragma unroll
                for (int bj = 0; bj < 2; ++bj) {
                    const int c = cbase + bj * HALF; const int head = c >> 6, d = c & 63;
                    const f32x4 v0 = acc[ai][bj][m][0] * rs, v1 = acc[ai][bj][m][1] * rs;
                    u32x4 w; w.x = cvt_pk_bf16(v0[0], v0[1]); w.y = cvt_pk_bf16(v0[2], v0[3]); w.z = cvt_pk_bf16(v1[0], v1[1]); w.w = cvt_pk_bf16(v1[2], v1[3]);
                    if (which < 2) {
                        bf16_t* dst = (which == 0 ? Q : Kb) + ((size_t)((b * 16 + head) * PP + pos)) * 64 + d;
                        *(u32x4*)dst = w;
                    } else {
                        PG8_LAS bf16_t* T = (PG8_LAS bf16_t*)(tl + (wr * 4 + wc) * 1536);
                        const int rb = 8 * fq * 24 + fr;
                        T[rb] = (bf16_t)(w.x & 0xffffu); T[rb + 24] = (bf16_t)(w.x >> 16); T[rb + 48] = (bf16_t)(w.y & 0xffffu); T[rb + 72] = (bf16_t)(w.y >> 16);
                        T[rb + 96] = (bf16_t)(w.z & 0xffffu); T[rb + 120] = (bf16_t)(w.z >> 16); T[rb + 144] = (bf16_t)(w.w & 0xffffu); T[rb + 168] = (bf16_t)(w.w >> 16);
                        const int L = fq * 16 + fr, dl = L >> 1, hf = L & 1;
                        const u32x4 tv = *(const PG8_LAS u32x4*)(T + dl * 24 + hf * 8);
                        const int pos0 = ((u.pm * BM + ai * HALF + wr * 64 + m * 16) & 4095) + 16;
                        const int dbase = (c & 63) - 8 * fq;
                        *(u32x4*)(Vt + ((size_t)((b * 16 + head) * 64 + dbase + dl)) * PP + pos0 + 8 * hf) = tv;
                    }
                }
            }
        ++ui;
    }
};
__device__ __forceinline__ float bflo(unsigned w) { return __builtin_bit_cast(float, w << 16); }
__device__ __forceinline__ float bfhi(unsigned w) { return __builtin_bit_cast(float, w & 0xffff0000u); }
struct EpiResid {
    static constexpr bool PERM = true, AFTER_DRAIN = false;
    bf16_t* hb; float* rowss_out;
    __device__ __forceinline__ void operator()(const f32x4 (&acc)[2][2][4][2], const Unit& u, int wr, int wc, int fr, int fq) const {
        const int col0 = u.pn * BM + wc * 32 + 8 * fq;
        u32x4 old[2][4][2];
#pragma unroll
        for (int ai = 0; ai < 2; ++ai)
#pragma unroll
            for (int m = 0; m < 4; ++m)
#pragma unroll
                for (int bj = 0; bj < 2; ++bj) old[ai][m][bj] = *(const u32x4*)(hb + (size_t)(u.pm * BM + ai * HALF + wr * 64 + m * 16 + fr) * 1024 + col0 + bj * HALF);
#pragma unroll
        for (int ai = 0; ai < 2; ++ai)
#pragma unroll
            for (int m = 0; m < 4; ++m) {
                const int row = u.pm * BM + ai * HALF + wr * 64 + m * 16 + fr; float ss = 0.f;
#pragma unroll
                for (int bj = 0; bj < 2; ++bj) {
                    const u32x4 ov = old[ai][m][bj]; const f32x4 a0 = acc[ai][bj][m][0], a1 = acc[ai][bj][m][1];
                    u32x4 w;
                    w.x = cvt_pk_bf16(bflo(ov.x) + a0[0], bfhi(ov.x) + a0[1]); w.y = cvt_pk_bf16(bflo(ov.y) + a0[2], bfhi(ov.y) + a0[3]);
                    w.z = cvt_pk_bf16(bflo(ov.z) + a1[0], bfhi(ov.z) + a1[1]); w.w = cvt_pk_bf16(bflo(ov.w) + a1[2], bfhi(ov.w) + a1[3]);
                    *(u32x4*)(hb + (size_t)row * 1024 + col0 + bj * HALF) = w;
#pragma unroll
                    for (int e = 0; e < 4; ++e) { const float lo = bflo(w[e]), hi = bfhi(w[e]); ss += lo * lo + hi * hi; }
                }
                ss += __shfl_xor(ss, 16); ss += __shfl_xor(ss, 32);
                if (fq == 0) atomicAdd(rowss_out + row, ss);
            }
    }
};
struct EpiFinal {
    static constexpr bool PERM = false, AFTER_DRAIN = true;
    const bf16_t* hb; float* rowss; float* out; const float* gfin; unsigned* cnt;
    __device__ __forceinline__ void fused(f32x4 (&acc)[2][2][4][2], const Unit& u, int wr, int wc, int fr, int fq, PG8_LAS unsigned char* lds, int wid, int lane) const {
        const int col0 = u.pn * BM + wc * 32 + 4 * fq;
        u32x2 old[2][4][2][2];
#pragma unroll
        for (int ai = 0; ai < 2; ++ai)
#pragma unroll
            for (int m = 0; m < 4; ++m)
#pragma unroll
                for (int bj = 0; bj < 2; ++bj)
#pragma unroll
                    for (int n = 0; n < 2; ++n) old[ai][m][bj][n] = *(const u32x2*)(hb + (size_t)(u.pm * BM + ai * HALF + wr * 64 + m * 16 + fr) * 1024 + col0 + bj * HALF + n * 16);
        f32x4 gv[2][2];
#pragma unroll
        for (int bj = 0; bj < 2; ++bj)
#pragma unroll
            for (int n = 0; n < 2; ++n) gv[bj][n] = *(const f32x4*)(gfin + col0 + bj * HALF + n * 16);
#pragma unroll
        for (int ai = 0; ai < 2; ++ai)
#pragma unroll
            for (int m = 0; m < 4; ++m) {
                const int row = u.pm * BM + ai * HALF + wr * 64 + m * 16 + fr; float ss = 0.f;
#pragma unroll
                for (int bj = 0; bj < 2; ++bj)
#pragma unroll
                    for (int n = 0; n < 2; ++n) { const u32x2 ov = old[ai][m][bj][n]; f32x4 v = acc[ai][bj][m][n];
                        v[0] += bflo(ov.x); v[1] += bfhi(ov.x); v[2] += bflo(ov.y); v[3] += bfhi(ov.y); acc[ai][bj][m][n] = v;
                        ss += (v[0] * v[0] + v[1] * v[1]) + (v[2] * v[2] + v[3] * v[3]); }
                ss += __shfl_xor(ss, 16); ss += __shfl_xor(ss, 32);
                if (fq == 0) __hip_atomic_fetch_add(rowss + row, ss, __ATOMIC_RELAXED, __HIP_MEMORY_SCOPE_AGENT);
            }
        asm volatile("s_waitcnt vmcnt(0)" ::: "memory");
        asm volatile("s_barrier" ::: "memory");
        if (wid == 0 && lane == 0) {
            __hip_atomic_fetch_add(cnt + u.pm, 1u, __ATOMIC_RELAXED, __HIP_MEMORY_SCOPE_AGENT);
            unsigned spins = 0;
            while (__hip_atomic_load(cnt + u.pm, __ATOMIC_RELAXED, __HIP_MEMORY_SCOPE_AGENT) < 4u) { __builtin_amdgcn_s_sleep(2); if (++spins > (1u << 22)) break; }
        }
        asm volatile("s_waitcnt vmcnt(0) lgkmcnt(0)\n\ts_barrier" ::: "memory");
        float ssv[2][4];
#pragma unroll
        for (int ai = 0; ai < 2; ++ai)
#pragma unroll
            for (int m = 0; m < 4; ++m) ssv[ai][m] = __hip_atomic_load(rowss + u.pm * BM + ai * HALF + wr * 64 + m * 16 + fr, __ATOMIC_RELAXED, __HIP_MEMORY_SCOPE_AGENT);
#pragma unroll
        for (int ai = 0; ai < 2; ++ai)
#pragma unroll
            for (int m = 0; m < 4; ++m) {
                const int row = u.pm * BM + ai * HALF + wr * 64 + m * 16 + fr;
                const float rs = rstd_of(ssv[ai][m]);
#pragma unroll
                for (int bj = 0; bj < 2; ++bj)
#pragma unroll
                    for (int n = 0; n < 2; ++n) *(f32x4*)(out + (size_t)row * 1024 + col0 + bj * HALF + n * 16) = acc[ai][bj][m][n] * rs * gv[bj][n];
            }
    }
};
struct EpiNull {
    static constexpr bool PERM = true, AFTER_DRAIN = false;
    float* dummy;
    __device__ __forceinline__ void operator()(const f32x4 (&acc)[2][2][4][2], const Unit& u, int wr, int wc, int fr, int fq) const {
        f32x4 s = {0.f, 0.f, 0.f, 0.f};
#pragma unroll
        for (int ai = 0; ai < 2; ++ai)
#pragma unroll
            for (int bj = 0; bj < 2; ++bj)
#pragma unroll
                for (int m = 0; m < 4; ++m)
#pragma unroll
                    for (int n = 0; n < 2; ++n) s += acc[ai][bj][m][n];
        dummy[(size_t)blockIdx.x * 512 + threadIdx.x] = (s[0] + s[1]) + (s[2] + s[3]);
    }
};
struct EpiUp {
    static constexpr bool PERM = true, AFTER_DRAIN = false;
    bf16_t* O; const float* rowss; const PG8_LAS float* rst; int nrst; mutable int ui = 0;
    __device__ __forceinline__ void operator()(const f32x4 (&acc)[2][2][4][2], const Unit& u, int wr, int wc, int fr, int fq) const {
        const int col0 = u.pn * BM + wc * 32 + 8 * fq;
#pragma unroll
        for (int ai = 0; ai < 2; ++ai)
#pragma unroll
            for (int m = 0; m < 4; ++m) {
                const int row = u.pm * BM + ai * HALF + wr * 64 + m * 16 + fr; const float rs = rst[ui * 256 + ai * HALF + wr * 64 + m * 16 + fr];
#pragma unroll
                for (int bj = 0; bj < 2; ++bj) {
                    f32x4 v0 = acc[ai][bj][m][0] * rs, v1 = acc[ai][bj][m][1] * rs;
#pragma unroll
                    for (int e = 0; e < 4; ++e) { const float a = fmaxf(v0[e], 0.f), b = fmaxf(v1[e], 0.f); v0[e] = a * a; v1[e] = b * b; }
                    u32x4 w; w.x = cvt_pk_bf16(v0[0], v0[1]); w.y = cvt_pk_bf16(v0[2], v0[3]); w.z = cvt_pk_bf16(v1[0], v1[1]); w.w = cvt_pk_bf16(v1[2], v1[3]);
                    st16_wt(O + (size_t)row * ACT_LD + col0 + bj * HALF, w);
                }
            }
        ++ui;
    }
};
__device__ __forceinline__ float gelu_tanh(float x) {
    const float y = 0.7978845608028654f * (x + 0.044715f * x * x * x);
    return x * __builtin_amdgcn_rcpf(1.0f + __builtin_amdgcn_exp2f(-2.0f * 1.4426950408889634f * y));
}
struct EpiWin {
    static constexpr bool PERM = true, AFTER_DRAIN = false;
    bf16_t* G; bf16_t* R; const float* rowss; const PG8_LAS float* rst; int nrst; mutable int ui = 0;
    __device__ __forceinline__ void operator()(const f32x4 (&acc)[2][2][4][2], const Unit& u, int wr, int wc, int fr, int fq) const {
        const int colt = u.pn * BM; const bool isgate = colt < 1024; const int col0 = (colt & 1023) + wc * 32 + 8 * fq; bf16_t* dstb = isgate ? G : R;
#pragma unroll
        for (int ai = 0; ai < 2; ++ai)
#pragma unroll
            for (int m = 0; m < 4; ++m) {
                const int row = u.pm * BM + ai * HALF + wr * 64 + m * 16 + fr; const float rs = rst[ui * 256 + ai * HALF + wr * 64 + m * 16 + fr];
#pragma unroll
                for (int bj = 0; bj < 2; ++bj) {
                    f32x4 v0 = acc[ai][bj][m][0] * rs, v1 = acc[ai][bj][m][1] * rs;
                    if (isgate) {
#pragma unroll
                        for (int e = 0; e < 4; ++e) { v0[e] = gelu_tanh(v0[e]); v1[e] = gelu_tanh(v1[e]); }
                    }
                    u32x4 w; w.x = cvt_pk_bf16(v0[0], v0[1]); w.y = cvt_pk_bf16(v0[2], v0[3]); w.z = cvt_pk_bf16(v1[0], v1[1]); w.w = cvt_pk_bf16(v1[2], v1[3]);
                    *(u32x4*)(dstb + (size_t)row * 1024 + col0 + bj * HALF) = w;
                }
            }
        ++ui;
    }
};
template <class Epi, class Sched, bool ALIGN_EPI = false, bool SP2 = false>
__device__ __forceinline__ void gemm_phase(PG8_LAS unsigned char* lds, const Gemm g, const Sched& S, const Epi& E) {
    const int tid = threadIdx.x, wid = __builtin_amdgcn_readfirstlane(tid >> 6), lane = tid & 63, wr = wid >> 2, wc = wid & 3, fr = lane & 15, fq = lane >> 4;
    const int K = g.K, nt = K / BK;
    unsigned voffA[2], voffB[2];
#pragma unroll
    for (int i = 0; i < 2; ++i) { int R, C; stage_rc(tid * 16 + i * 8192, R, C); const int Rb = Epi::PERM ? ((R & ~31) + perm32(R & 31)) : R;
        voffA[i] = (unsigned)(R * g.lda + C) * 2u; voffB[i] = (unsigned)(Rb * g.ldb + C) * 2u; }
    const size_t kstep = (size_t)(BK * 2);
    const size_t hstepA = (size_t)HALF * g.lda * 2, hstepB = (size_t)HALF * g.ldb * 2;
    const size_t tstepA = 2 * hstepA, tstepB = 2 * hstepB;
    const unsigned ldsw = (unsigned)wid * 1024u;
    const int aoff = lds_byte(wr * 64 + fr, fq * 8), boff = lds_byte(wc * 32 + fr, fq * 8);
#define PG8_SA(b, h) (((b) * 2 + (h)) * HTB)
#define PG8_SB(b, h) ((4 + (b) * 2 + (h)) * HTB)
#define PG8_STAGE(bufoff, gbase, voff) do { _Pragma("unroll") for (int _i = 0; _i < 2; ++_i) \
        __builtin_amdgcn_global_load_lds((const unsigned*)((const char*)(gbase) + (voff)[_i]), (PG8_LAS unsigned*)(lds + (bufoff) + ldsw + _i * 8192), 16, 0, 0); } while (0)
#define PG8_LDA(dst, b, h) do { _Pragma("unroll") for (int m = 0; m < 4; ++m) _Pragma("unroll") for (int k = 0; k < 2; ++k) dst[m][k] = *(const PG8_LAS bf16x8*)(lds + PG8_SA(b, h) + aoff + m * 2048 + k * 1024); } while (0)
#define PG8_LDB(dst, b, h) do { _Pragma("unroll") for (int n = 0; n < 2; ++n) _Pragma("unroll") for (int k = 0; k < 2; ++k) dst[n][k] = *(const PG8_LAS bf16x8*)(lds + PG8_SB(b, h) + boff + n * 2048 + k * 1024); } while (0)
#define PG8_MMA(ai, bj, At, Bt) do { __builtin_amdgcn_s_setprio(1); _Pragma("unroll") for (int m = 0; m < 4; ++m) _Pragma("unroll") for (int n = 0; n < 2; ++n) _Pragma("unroll") for (int k = 0; k < 2; ++k) \
        acc[ai][bj][m][n] = __builtin_amdgcn_mfma_f32_16x16x32_bf16(Bt[n][k], At[m][k], acc[ai][bj][m][n], 0, 0, 0); __builtin_amdgcn_s_setprio(0); } while (0)
#define PG8_WAIT_V(n) asm volatile("s_waitcnt vmcnt(" #n ")" ::: "memory")
#define PG8_WAIT_L(n) asm volatile("s_waitcnt lgkmcnt(" #n ")" ::: "memory")
#define PG8_BAR __builtin_amdgcn_s_barrier()
#define PG8_SCHED __builtin_amdgcn_sched_barrier(0)
    Unit cur, nxt; int ui = 0;
    if (!S.next(0, cur)) return;
    f32x4 acc[2][2][4][2];
#pragma unroll
    for (int a = 0; a < 2; ++a)
#pragma unroll
        for (int b = 0; b < 2; ++b)
#pragma unroll
            for (int m = 0; m < 4; ++m)
#pragma unroll
                for (int n = 0; n < 2; ++n) acc[a][b][m][n] = (f32x4){0.f, 0.f, 0.f, 0.f};
    bf16x8 At[4][2], B0[2][2], B1[2][2];
    const char* cA = (const char*)g.A + (size_t)cur.pm * tstepA; const char* cB = (const char*)g.Bt + (size_t)cur.pn * tstepB;
    S.a_ready(cur);
    if constexpr (SP2) {
        PG8_STAGE(PG8_SB(0, 0), cB, voffB); PG8_STAGE(PG8_SB(0, 1), cB + hstepB, voffB); PG8_STAGE(PG8_SA(0, 0), cA, voffA); PG8_STAGE(PG8_SA(0, 1), cA + hstepA, voffA);
        if (wr == 1) PG8_BAR;
        PG8_WAIT_V(2); PG8_BAR;
        PG8_STAGE(PG8_SB(1, 0), cB + kstep, voffB); PG8_STAGE(PG8_SA(1, 0), cA + kstep, voffA); PG8_STAGE(PG8_SB(1, 1), cB + hstepB + kstep, voffB);
        PG8_WAIT_V(6); PG8_BAR;
    } else {
        PG8_STAGE(PG8_SB(0, 0), cB, voffB); PG8_STAGE(PG8_SA(0, 0), cA, voffA); PG8_STAGE(PG8_SB(0, 1), cB + hstepB, voffB); PG8_STAGE(PG8_SA(0, 1), cA + hstepA, voffA);
        if (wr == 1) PG8_BAR;
        PG8_WAIT_V(4); PG8_BAR;
        PG8_STAGE(PG8_SB(1, 0), cB + kstep, voffB); PG8_STAGE(PG8_SA(1, 0), cA + kstep, voffA); PG8_STAGE(PG8_SB(1, 1), cB + hstepB + kstep, voffB);
        PG8_WAIT_V(6); PG8_BAR;
    }
    for (;;) {
        const bool has_next = S.next(ui + 1, nxt);
        const char* nA = has_next ? (const char*)g.A + (size_t)nxt.pm * tstepA : cA; const char* nB = has_next ? (const char*)g.Bt + (size_t)nxt.pn * tstepB : cB;
        for (int t = 0; t < nt; t += 2) {
            const bool last = (t == nt - 2);
            const char* a1 = cA + (size_t)(t + 1) * kstep;
            const char* a2 = last ? nA : cA + (size_t)(t + 2) * kstep; const char* b2 = last ? nB : cB + (size_t)(t + 2) * kstep;
            const char* a3 = a2 + kstep; const char* b3 = b2 + kstep;
            if (last && has_next) S.a_ready(nxt);
            if constexpr (SP2) {
            PG8_LDB(B0, 0, 0); PG8_LDB(B1, 0, 1); PG8_SCHED; PG8_LDA(At, 0, 0); PG8_STAGE(PG8_SA(1, 1), a1 + hstepA, voffA);
            PG8_WAIT_V(8); PG8_WAIT_L(0); PG8_BAR; PG8_MMA(0, 0, At, B0); PG8_MMA(0, 1, At, B1); PG8_BAR; PG8_SCHED;
            PG8_LDA(At, 0, 1); PG8_STAGE(PG8_SB(0, 0), b2, voffB); PG8_STAGE(PG8_SB(0, 1), b2 + hstepB, voffB); PG8_STAGE(PG8_SA(0, 0), a2, voffA);
            PG8_WAIT_V(8); PG8_WAIT_L(0); PG8_BAR; PG8_MMA(1, 0, At, B0); PG8_MMA(1, 1, At, B1); PG8_BAR; PG8_SCHED;
            PG8_LDB(B0, 1, 0); PG8_LDB(B1, 1, 1); PG8_SCHED; PG8_LDA(At, 1, 0); PG8_STAGE(PG8_SA(0, 1), a2 + hstepA, voffA);
            PG8_WAIT_V(8); PG8_WAIT_L(0); PG8_BAR; PG8_MMA(0, 0, At, B0); PG8_MMA(0, 1, At, B1); PG8_BAR; PG8_SCHED;
            PG8_LDA(At, 1, 1); PG8_STAGE(PG8_SB(1, 0), b3, voffB); PG8_STAGE(PG8_SB(1, 1), b3 + hstepB, voffB); PG8_STAGE(PG8_SA(1, 0), a3, voffA);
            PG8_WAIT_V(8); PG8_WAIT_L(0); PG8_BAR; PG8_MMA(1, 0, At, B0); PG8_MMA(1, 1, At, B1); PG8_BAR; PG8_SCHED;
            } else {
            PG8_LDB(B0, 0, 0); PG8_SCHED; PG8_LDA(At, 0, 0); PG8_STAGE(PG8_SA(1, 1), a1 + hstepA, voffA);
            PG8_WAIT_L(8); PG8_BAR; PG8_WAIT_L(0); PG8_MMA(0, 0, At, B0); PG8_BAR; PG8_SCHED;
            PG8_LDB(B1, 0, 1); PG8_STAGE(PG8_SB(0, 0), b2, voffB);
            PG8_BAR; PG8_WAIT_L(0); PG8_MMA(0, 1, At, B1); PG8_BAR;
            PG8_LDA(At, 0, 1); PG8_STAGE(PG8_SA(0, 0), a2, voffA);
            PG8_BAR; PG8_WAIT_L(0); PG8_MMA(1, 0, At, B0); PG8_BAR; PG8_SCHED;
            PG8_STAGE(PG8_SB(0, 1), b2 + hstepB, voffB);
            PG8_WAIT_V(6); PG8_BAR; PG8_MMA(1, 1, At, B1); PG8_BAR;
            PG8_LDB(B0, 1, 0); PG8_SCHED; PG8_LDA(At, 1, 0); PG8_STAGE(PG8_SA(0, 1), a2 + hstepA, voffA);
            PG8_WAIT_L(8); PG8_BAR; PG8_WAIT_L(0); PG8_MMA(0, 0, At, B0); PG8_BAR; PG8_SCHED;
            PG8_LDB(B1, 1, 1); PG8_STAGE(PG8_SB(1, 0), b3, voffB);
            PG8_BAR; PG8_WAIT_L(0); PG8_MMA(0, 1, At, B1); PG8_BAR;
            PG8_LDA(At, 1, 1); PG8_STAGE(PG8_SA(1, 0), a3, voffA);
            PG8_BAR; PG8_WAIT_L(0); PG8_MMA(1, 0, At, B0); PG8_BAR; PG8_SCHED;
            PG8_STAGE(PG8_SB(1, 1), b3 + hstepB, voffB);
            PG8_WAIT_V(6); PG8_BAR; PG8_MMA(1, 1, At, B1); PG8_BAR;
            }
        }
        if constexpr (ALIGN_EPI) { if (wr == 0) PG8_BAR; }
        if constexpr (!Epi::AFTER_DRAIN) { E(acc, cur, wr, wc, fr, fq); S.done(cur); }
        if (!has_next) break;
#pragma unroll
        for (int a = 0; a < 2; ++a)
#pragma unroll
            for (int b = 0; b < 2; ++b)
#pragma unroll
                for (int m = 0; m < 4; ++m)
#pragma unroll
                    for (int n = 0; n < 2; ++n) acc[a][b][m][n] = (f32x4){0.f, 0.f, 0.f, 0.f};
        cur = nxt; cA = nA; cB = nB; ++ui;
        if constexpr (ALIGN_EPI) { if (wr == 1) PG8_BAR; }
    }
    PG8_WAIT_V(0);
    if constexpr (!ALIGN_EPI) { if (wr == 0) PG8_BAR; }
    PG8_BAR;
    if constexpr (Epi::AFTER_DRAIN) { E.fused(acc, cur, wr, wc, fr, fq, lds, wid, lane); S.done(cur); }
#undef PG8_SA
#undef PG8_SB
#undef PG8_STAGE
#undef PG8_LDA
#undef PG8_LDB
#undef PG8_MMA
#undef PG8_WAIT_V
#undef PG8_WAIT_L
#undef PG8_BAR
#undef PG8_SCHED
}
}
#define LAS __attribute__((address_space(3)))
typedef unsigned short bf16;
typedef float f32x4 __attribute__((ext_vector_type(4)));
typedef float f32x16 __attribute__((ext_vector_type(16)));
typedef short bf16x8 __attribute__((ext_vector_type(8)));
typedef unsigned u32x4 __attribute__((ext_vector_type(4)));
typedef unsigned u32x2 __attribute__((ext_vector_type(2)));
constexpr int NWAVES = 8, NTHREADS = 512;
constexpr int NREAL = 16384, MBASE = 16384, MALLOC = 16448, DM = 1024, FF = 4096, PP = pg8::PP;
constexpr float QSCALE = 0.125f * 1.4426950408889634f;
constexpr size_t MiB = 1u << 20;
constexpr size_t WS_ROWSS = 0;
constexpr size_t WS_HMETA = 512 * 1024;
constexpr size_t WS_HMEND = 640 * 1024;
constexpr size_t WS_PCNT = 704 * 1024;
constexpr size_t WS_SFLAG = 736 * 1024;
constexpr size_t WS_BAR = 768 * 1024;
constexpr size_t WS_CARA = 1 * MiB, WS_CARB = 2 * MiB;
constexpr int ACT_LD = pg8::ACT_LD;
constexpr size_t KiB256 = 256 * 1024;
constexpr size_t WS_WQKV = 4 * MiB, WS_WO = 10 * MiB, WS_WUP0 = 12 * MiB, WS_WDN0 = 20 * MiB, WS_WIN = 28 * MiB + KiB256, WS_WRG = 32 * MiB + KiB256, WS_WIG = 32 * MiB + 2 * KiB256,
                 WS_WOUT = 33 * MiB + KiB256, WS_WUP1 = 35 * MiB + KiB256, WS_WDN1 = 43 * MiB + KiB256;
static_assert(WS_WDN0 + (size_t)1024 * ACT_LD * 2 <= WS_WIN && WS_WDN1 + (size_t)1024 * ACT_LD * 2 <= 52 * MiB, "weight map");
constexpr size_t WS_HB = 52 * MiB;
constexpr size_t WS_A = 85 * MiB;
constexpr size_t QKV_BYTES = (size_t)64 * PP * 64 * 2;
constexpr size_t ROWARR = (size_t)MALLOC * 1024 * 2;
constexpr size_t WS_Q = WS_A, WS_K = WS_A + QKV_BYTES, WS_VT = WS_A + 2 * QKV_BYTES, WS_O = WS_A + 3 * QKV_BYTES;
constexpr size_t WS_ACT = WS_A;
constexpr size_t WS_GATE = WS_A, WS_REC = WS_A + ROWARR, WS_HL = WS_A + 2 * ROWARR, WS_PC = WS_A + 3 * ROWARR;
constexpr size_t WS_Y = 216 * MiB;
constexpr size_t WS_END = WS_Y + ROWARR;
static_assert(WS_O + ROWARR <= WS_Y && WS_ACT + (size_t)(MBASE + 16) * ACT_LD * 2 <= WS_Y && WS_PC + ROWARR <= WS_Y && WS_END <= 256 * MiB, "ws map");
constexpr int LDS_BYTES = 163840;

struct Args {
    const float* in[18]; float* out; unsigned char* ws; int ph_lo, ph_hi;
};

__device__ __forceinline__ unsigned f2bf(float f) { unsigned u = __builtin_bit_cast(unsigned, f); return (u + 0x7fffu + ((u >> 16) & 1u)) >> 16; }
__device__ __forceinline__ unsigned pk2(float lo, float hi) { return f2bf(lo) | (f2bf(hi) << 16); }
__device__ __forceinline__ float bf2f(unsigned short v) { return __builtin_bit_cast(float, (unsigned)v << 16); }
__device__ __forceinline__ float wave_sum(float v) {
#pragma unroll
    for (int o = 1; o < 64; o <<= 1) v += __shfl_xor(v, o);
    return v;
}
__device__ __forceinline__ void p0_transpose_item(const float* W, int K, int N, bf16* WT, const float* gain, float* scr, int item, int lane, int ldt = 0) {
    if (ldt == 0) ldt = K;
    const int nblk = N / 32, kb = item / nblk, nb = item % nblk, k0 = 64 * kb, n0 = 32 * nb;
    {
        const int rr = lane >> 3, c4 = (lane & 7) * 4;
        f32x4 v[8];
#pragma unroll
        for (int i = 0; i < 8; ++i) v[i] = __builtin_nontemporal_load((const f32x4*)(W + (size_t)(k0 + 8 * i + rr) * N + n0 + c4));
#pragma unroll
        for (int i = 0; i < 8; ++i) { const int kk = 8 * i + rr; const float gk = gain ? gain[k0 + kk] : 1.0f;
            scr[kk * 33 + c4] = v[i][0] * gk; scr[kk * 33 + c4 + 1] = v[i][1] * gk; scr[kk * 33 + c4 + 2] = v[i][2] * gk; scr[kk * 33 + c4 + 3] = v[i][3] * gk; }
    }
    asm volatile("s_waitcnt lgkmcnt(0)" ::: "memory");
    const int c = lane & 7;
#pragma unroll
    for (int j = 0; j < 4; ++j) { const int n = (lane >> 3) + 8 * j; const float* s = scr + (8 * c) * 33 + n;
        u32x4 o; o.x = pk2(s[0 * 33], s[1 * 33]); o.y = pk2(s[2 * 33], s[3 * 33]); o.z = pk2(s[4 * 33], s[5 * 33]); o.w = pk2(s[6 * 33], s[7 * 33]);
        *(u32x4*)(WT + (size_t)(n0 + n) * ldt + k0 + 8 * c) = o; }
    asm volatile("s_waitcnt lgkmcnt(0)" ::: "memory");
}
__device__ __forceinline__ void prologue(const Args& a, unsigned char* lds, int gw, int NGW, int wid, int lane) {
    unsigned char* ws = a.ws;
    float* scr = (float*)(lds + wid * 16384);
    const float* norm_mix = a.in[2]; const float* norm_mlp = a.in[3];
    constexpr int I_QKV = 16 * 96, I_O = 16 * 32, I_UP = 16 * 128, I_DN = 64 * 32, I_IN = 16 * 64, I_G = 2 * 4;
    constexpr int NITEMS = I_QKV + I_O + 2 * I_UP + 2 * I_DN + I_IN + 16 * I_G + I_O;
    for (int it = gw; it < NITEMS; it += NGW) {
        int r = it;
        if (r < I_QKV) { p0_transpose_item(a.in[4], 1024, 3072, (bf16*)(ws + WS_WQKV), norm_mix, scr, r, lane); continue; } r -= I_QKV;
        if (r < I_O) { p0_transpose_item(a.in[5], 1024, 1024, (bf16*)(ws + WS_WO), nullptr, scr, r, lane); continue; } r -= I_O;
        if (r < I_UP) { p0_transpose_item(a.in[15], 1024, 4096, (bf16*)(ws + WS_WUP0), norm_mlp, scr, r, lane); continue; } r -= I_UP;
        if (r < I_UP) { p0_transpose_item(a.in[15] + (size_t)1024 * 4096, 1024, 4096, (bf16*)(ws + WS_WUP1), norm_mlp + 1024, scr, r, lane); continue; } r -= I_UP;
        if (r < I_DN) { p0_transpose_item(a.in[16], 4096, 1024, (bf16*)(ws + WS_WDN0), nullptr, scr, r, lane, ACT_LD); continue; } r -= I_DN;
        if (r < I_DN) { p0_transpose_item(a.in[16] + (size_t)4096 * 1024, 4096, 1024, (bf16*)(ws + WS_WDN1), nullptr, scr, r, lane, ACT_LD); continue; } r -= I_DN;
        if (r < I_IN) { p0_transpose_item(a.in[6], 1024, 2048, (bf16*)(ws + WS_WIN), norm_mix + 1024, scr, r, lane); continue; } r -= I_IN;
        if (r < 8 * I_G) { const int n = r / I_G; p0_transpose_item(a.in[9] + (size_t)n * 16384, 128, 128, (bf16*)(ws + WS_WRG) + (size_t)n * 16384, nullptr, scr, r % I_G, lane); continue; } r -= 8 * I_G;
        if (r < 8 * I_G) { const int n = r / I_G; p0_transpose_item(a.in[11] + (size_t)n * 16384, 128, 128, (bf16*)(ws + WS_WIG) + (size_t)n * 16384, nullptr, scr, r % I_G, lane); continue; } r -= 8 * I_G;
        p0_transpose_item(a.in[14], 1024, 1024, (bf16*)(ws + WS_WOUT), nullptr, scr, r, lane);
    }
    float* rowss = (float*)(ws + WS_ROWSS); bf16* hb = (bf16*)(ws + WS_HB);
    for (int m0 = 2 * gw; m0 < NREAL + 16; m0 += 2 * NGW) {
        f32x4 v[2][4];
#pragma unroll
        for (int k = 0; k < 2; ++k) { const int m = m0 + k; const float* src = (m < NREAL) ? a.in[0] + (size_t)m * 1024 : a.in[1] + (size_t)(m - NREAL) * 1024;
            const f32x4* xr = (const f32x4*)src + lane;
#pragma unroll
            for (int j = 0; j < 4; ++j) v[k][j] = __builtin_nontemporal_load(xr + 64 * j); }
#pragma unroll
        for (int k = 0; k < 2; ++k) { const int m = m0 + k; float s = 0.f;
            unsigned long long* o8 = (unsigned long long*)(hb + (size_t)m * 1024) + lane;
#pragma unroll
            for (int j = 0; j < 4; ++j) { const f32x4 t = v[k][j]; s += (t.x * t.x + t.y * t.y) + (t.z * t.z + t.w * t.w);
                o8[64 * j] = (unsigned long long)pk2(t.x, t.y) | ((unsigned long long)pk2(t.z, t.w) << 32); }
            s = wave_sum(s); if (lane == 0) rowss[m] = s; }
    }
    for (int i = gw * 64 + lane; i < 4 * MALLOC; i += NGW * 64) rowss[MALLOC + i] = 0.f;
    if (gw == 0) ((unsigned*)(ws + WS_PCNT))[lane] = 0u;
    if (gw == 1) { unsigned* sf = (unsigned*)(ws + WS_SFLAG); sf[lane] = 0u; sf[64 + lane] = 0u; sf[128 + lane] = 0u; sf[192 + lane] = 0u; }
}

template <int K, int LD = K> __device__ __forceinline__ f32x4 skinny_tile(const bf16* A, const bf16* Bt, int n0, unsigned char* lds, int wid, int lane) {
    const int r = lane & 15, kq = lane >> 4; constexpr int ks = K >> 3, NS = ks / 32;
    const bf16* ap = A + (size_t)r * LD + wid * ks + 8 * kq; const bf16* bp = Bt + (size_t)(n0 + r) * LD + wid * ks + 8 * kq;
    bf16x8 av[NS], bv[NS];
#pragma unroll
    for (int k = 0; k < NS; ++k) { av[k] = *(const bf16x8*)(ap + 32 * k); bv[k] = *(const bf16x8*)(bp + 32 * k); }
    f32x4 acc = {0.f, 0.f, 0.f, 0.f};
#pragma unroll
    for (int k = 0; k < NS; ++k) acc = __builtin_amdgcn_mfma_f32_16x16x32_bf16(bv[k], av[k], acc, 0, 0, 0);
    f32x4* red = (f32x4*)lds;
    red[wid * 64 + lane] = acc;
    __syncthreads();
    f32x4 sum = {0.f, 0.f, 0.f, 0.f};
    if (wid == 0) {
#pragma unroll
        for (int w = 0; w < 8; ++w) sum += red[w * 64 + lane];
    }
    __syncthreads();
    return sum;
}
enum { SK_QKV = 0, SK_OPROJ = 1, SK_UP = 2, SK_DOWN = 3, SK_WIN = 4 };
template <int MODE> __device__ __forceinline__ void skinny_phase(const Args& a, unsigned char* lds, int G, int wid, int lane) {
    unsigned char* ws = a.ws; float* rowss = (float*)(ws + WS_ROWSS); bf16* hb = (bf16*)(ws + WS_HB); float* hmeta = (float*)(ws + WS_HMETA);
    constexpr int NIT = MODE == SK_QKV ? 192 : MODE == SK_UP ? 256 : 64;
    for (int item = blockIdx.x; item < NIT; item += G) {
        const int m = lane & 15, nq = lane >> 4, MR = MBASE + m;
        if (MODE == SK_QKV) {
            const int n0 = 16 * item; const f32x4 acc = skinny_tile<1024>(hb + (size_t)MBASE * 1024, (const bf16*)(ws + WS_WQKV), n0, lds, wid, lane);
            if (wid == 0) {
                const int n = n0 + 4 * nq, which = n >> 10, c = n & 1023, head = c >> 6, d = c & 63;
                float rs = pg8::rstd_of(rowss[MR]); if (which == 0) rs *= QSCALE;
                const unsigned w0 = pk2(acc[0] * rs, acc[1] * rs), w1 = pk2(acc[2] * rs, acc[3] * rs);
                for (int b = 0; b < 4; ++b) {
                    if (which < 2) { bf16* dst = (bf16*)(ws + (which == 0 ? WS_Q : WS_K)) + ((size_t)((b * 16 + head) * PP + m)) * 64 + d; u32x2 w; w.x = w0; w.y = w1; *(u32x2*)dst = w; }
                    else { bf16* dst = (bf16*)(ws + WS_VT) + ((size_t)((b * 16 + head) * 64 + d)) * PP + m;
                        dst[0] = (bf16)(w0 & 0xffffu); dst[PP] = (bf16)(w0 >> 16); dst[2 * PP] = (bf16)(w1 & 0xffffu); dst[3 * PP] = (bf16)(w1 >> 16); }
                }
            }
        } else if (MODE == SK_OPROJ || MODE == SK_DOWN) {
            const int n0 = 16 * item;
            const f32x4 acc = (MODE == SK_OPROJ) ? skinny_tile<1024>((const bf16*)(ws + WS_O) + (size_t)MBASE * 1024, (const bf16*)(ws + WS_WO), n0, lds, wid, lane)
                                                 : skinny_tile<4096, ACT_LD>((const bf16*)(ws + WS_ACT) + (size_t)MBASE * ACT_LD, (const bf16*)(ws + WS_WDN0), n0, lds, wid, lane);
            if (wid == 0) {
                const int n = n0 + 4 * nq; const float* base = (MODE == SK_OPROJ) ? a.in[1] : hmeta;
                const f32x4 o = *(const f32x4*)(base + m * 1024 + n) + acc;
                *(f32x4*)(hmeta + m * 1024 + n) = o;
                u32x2 w; w.x = pk2(o[0], o[1]); w.y = pk2(o[2], o[3]); *(u32x2*)(hb + (size_t)MR * 1024 + n) = w;
                float ss = (o[0] * o[0] + o[1] * o[1]) + (o[2] * o[2] + o[3] * o[3]); ss += __shfl_xor(ss, 16); ss += __shfl_xor(ss, 32);
                if (nq == 0) atomicAdd(rowss + (MODE == SK_OPROJ ? 1 : 2) * MALLOC + MR, ss);
            }
        } else if (MODE == SK_UP) {
            const int n0 = 16 * item; const f32x4 acc = skinny_tile<1024>(hb + (size_t)MBASE * 1024, (const bf16*)(ws + WS_WUP0), n0, lds, wid, lane);
            if (wid == 0) {
                const int n = n0 + 4 * nq; const float rs = pg8::rstd_of(rowss[1 * MALLOC + MR]);
                float v[4];
#pragma unroll
                for (int e = 0; e < 4; ++e) { const float t = fmaxf(acc[e] * rs, 0.f); v[e] = t * t; }
                u32x2 w; w.x = pk2(v[0], v[1]); w.y = pk2(v[2], v[3]); *(u32x2*)((bf16*)(ws + WS_ACT) + (size_t)MR * ACT_LD + n) = w;
            }
        } else {
            const int n0 = 1024 + 16 * item; const f32x4 acc = skinny_tile<1024>(hb + (size_t)MBASE * 1024, (const bf16*)(ws + WS_WIN), n0, lds, wid, lane);
            if (wid == 0) {
                const int n = n0 + 4 * nq - 1024; const float rs = pg8::rstd_of(rowss[2 * MALLOC + MR]);
                u32x2 w; w.x = pk2(acc[0] * rs, acc[1] * rs); w.y = pk2(acc[2] * rs, acc[3] * rs); *(u32x2*)((bf16*)(ws + WS_REC) + (size_t)MR * 1024 + n) = w;
            }
        }
    }
}

__device__ __forceinline__ void attn_half(const bf16x8 (&kf)[4], const bf16x8 (&vf)[2][2], const bf16x8 (&qf)[4], float& Prun, f32x16& o0, f32x16& o1, int key0, int qp, int hi) {
    f32x16 s;
#pragma unroll
    for (int r = 0; r < 16; ++r) s[r] = 0.f;
#pragma unroll
    for (int dc = 0; dc < 4; ++dc) s = __builtin_amdgcn_mfma_f32_32x32x16_bf16(kf[dc], qf[dc], s, 0, 0, 0);
    float kap[16];
#pragma unroll
    for (int r = 0; r < 16; ++r) {
        const int key = key0 + 16 * (r >> 3) + 8 * hi + (r & 7);
        const float kk = __builtin_amdgcn_rcpf(1.0f + __builtin_amdgcn_exp2f(s[r]));
        kap[r] = ((key < qp) && (key >= 0)) ? kk : 1.f;
    }
    float cc[16]; float t1 = 1.f, t0 = 1.f;
#pragma unroll
    for (int r = 15; r >= 8; --r) { cc[r] = t1; t1 *= kap[r]; }
#pragma unroll
    for (int r = 7; r >= 0; --r) { cc[r] = t0; t0 *= kap[r]; }
    const float G1 = t1, G0 = t0;
    const float G0o = __shfl_xor(G0, 32), G1o = __shfl_xor(G1, 32);
    const float pre1 = hi ? Prun : Prun * G1o;
    const float pre0 = hi ? Prun * G1 * G1o : Prun * G1o * G1 * G0o;
    Prun = Prun * G1 * G1o * G0 * G0o;
    float w[16];
#pragma unroll
    for (int r = 15; r >= 9; --r) w[r] = pre1 * (cc[r] - cc[r - 1]);
    w[8] = pre1 * (cc[8] - G1);
#pragma unroll
    for (int r = 7; r >= 1; --r) w[r] = pre0 * (cc[r] - cc[r - 1]);
    w[0] = pre0 * (cc[0] - G0);
    u32x4 p0, p1;
    p0.x = pg8::cvt_pk_bf16(w[0], w[1]); p0.y = pg8::cvt_pk_bf16(w[2], w[3]); p0.z = pg8::cvt_pk_bf16(w[4], w[5]); p0.w = pg8::cvt_pk_bf16(w[6], w[7]);
    p1.x = pg8::cvt_pk_bf16(w[8], w[9]); p1.y = pg8::cvt_pk_bf16(w[10], w[11]); p1.z = pg8::cvt_pk_bf16(w[12], w[13]); p1.w = pg8::cvt_pk_bf16(w[14], w[15]);
    const bf16x8 pf0 = __builtin_bit_cast(bf16x8, p0), pf1 = __builtin_bit_cast(bf16x8, p1);
    o0 = __builtin_amdgcn_mfma_f32_32x32x16_bf16(vf[0][0], pf0, o0, 0, 0, 0);
    o0 = __builtin_amdgcn_mfma_f32_32x32x16_bf16(vf[0][1], pf1, o0, 0, 0, 0);
    o1 = __builtin_amdgcn_mfma_f32_32x32x16_bf16(vf[1][0], pf0, o1, 0, 0, 0);
    o1 = __builtin_amdgcn_mfma_f32_32x32x16_bf16(vf[1][1], pf1, o1, 0, 0, 0);
}
__device__ __forceinline__ void attn_store(bf16* O, int row, int h, int hi, const f32x16& o0, const f32x16& o1) {
    bf16* op = O + (size_t)row * 1024 + h * 64 + 4 * hi;
#pragma unroll
    for (int g4 = 0; g4 < 4; ++g4) {
        u32x2 wa; wa.x = pg8::cvt_pk_bf16(o0[4 * g4], o0[4 * g4 + 1]); wa.y = pg8::cvt_pk_bf16(o0[4 * g4 + 2], o0[4 * g4 + 3]); *(u32x2*)(op + 8 * g4) = wa;
        u32x2 wb; wb.x = pg8::cvt_pk_bf16(o1[4 * g4], o1[4 * g4 + 1]); wb.y = pg8::cvt_pk_bf16(o1[4 * g4 + 2], o1[4 * g4 + 3]); *(u32x2*)(op + 32 + 8 * g4) = wb;
    }
}
__device__ __forceinline__ void attn_phase(const bf16* Q, const bf16* Kb, const bf16* Vt, bf16* O, int gw, int NGW, int lane) {
    const int q = lane & 31, hi = lane >> 5;
    const int pi = (q & 0x13) | ((q & 4) << 1) | ((q & 8) >> 1);
    for (int item = gw; item < 4096 + 16; item += NGW) {
        const bool metaq = item >= 4096;
        const int bh = metaq ? item - 4096 : (item & 63), j2 = metaq ? -1 : (item >> 6), b = bh >> 4, h = bh & 15;
        const size_t base = (size_t)bh * PP;
        const int q0 = 16 + 64 * j2;
        const int qpA = metaq ? q : q0 + q, qpB = metaq ? -1 : q0 + 32 + q;
        const bool validA = metaq ? (q < 16) : true, validB = !metaq;
        bf16x8 qfA[4], qfB[4];
#pragma unroll
        for (int dc = 0; dc < 4; ++dc) { qfA[dc] = *(const bf16x8*)(Q + (base + qpA) * 64 + 16 * dc + 8 * hi); qfB[dc] = *(const bf16x8*)(Q + (base + (qpB < 0 ? 0 : qpB)) * 64 + 16 * dc + 8 * hi); }
        f32x16 oA0, oA1, oB0, oB1;
#pragma unroll
        for (int r = 0; r < 16; ++r) { oA0[r] = 0.f; oA1[r] = 0.f; oB0[r] = 0.f; oB1[r] = 0.f; }
        float PrunA = validA ? 1.0f : 0.0f, PrunB = validB ? 1.0f : 0.0f;
        const int nunits = metaq ? 1 : 2 * j2 + 3;
        const int kfirst = metaq ? -16 : q0 + 32;
        bf16x8 kfn[4], vfn[2][2];
        {
            const int kk = kfirst + pi; const bf16* kp = Kb + (base + (kk < 0 ? 0 : kk)) * 64 + 8 * hi;
#pragma unroll
            for (int dc = 0; dc < 4; ++dc) kfn[dc] = *(const bf16x8*)(kp + 16 * dc);
#pragma unroll
            for (int db = 0; db < 2; ++db)
#pragma unroll
                for (int c = 0; c < 2; ++c) { const int col = kfirst + 16 * c + 8 * hi; vfn[db][c] = *(const bf16x8*)(Vt + ((size_t)(bh * 64 + db * 32 + q)) * PP + (col < 0 ? 0 : col)); }
        }
        for (int u = 0; u < nunits; ++u) {
            const int key0 = kfirst - 32 * u;
            bf16x8 kf[4], vf[2][2];
#pragma unroll
            for (int dc = 0; dc < 4; ++dc) kf[dc] = kfn[dc];
#pragma unroll
            for (int db = 0; db < 2; ++db)
#pragma unroll
                for (int c = 0; c < 2; ++c) vf[db][c] = vfn[db][c];
            if (u + 1 < nunits) {
                const int k1 = key0 - 32; const int kk = k1 + pi; const bf16* kp = Kb + (base + (kk < 0 ? 0 : kk)) * 64 + 8 * hi;
#pragma unroll
                for (int dc = 0; dc < 4; ++dc) kfn[dc] = *(const bf16x8*)(kp + 16 * dc);
#pragma unroll
                for (int db = 0; db < 2; ++db)
#pragma unroll
                    for (int c = 0; c < 2; ++c) { const int col = k1 + 16 * c + 8 * hi; vfn[db][c] = *(const bf16x8*)(Vt + ((size_t)(bh * 64 + db * 32 + q)) * PP + (col < 0 ? 0 : col)); }
            }
            attn_half(kf, vf, qfA, PrunA, oA0, oA1, key0, qpA, hi);
            attn_half(kf, vf, qfB, PrunB, oB0, oB1, key0, qpB, hi);
            if (__all((PrunA < 1e-37f) && (PrunB < 1e-37f))) break;
        }
        if (validA) attn_store(O, metaq ? MBASE + q : b * 4096 + qpA - 16, h, hi, oA0, oA1);
        if (validB) attn_store(O, b * 4096 + qpB - 16, h, hi, oB0, oB1);
    }
}
__device__ __forceinline__ float sigmoidf_(float x) { return __builtin_amdgcn_rcpf(1.0f + __builtin_amdgcn_exp2f(-1.4426950408889634f * x)); }
#define LDS_BAR() asm volatile("s_waitcnt lgkmcnt(0)\n\ts_barrier" ::: "memory")
__device__ __forceinline__ void scan_phase(const Args& a, unsigned char* lds, int G, int tid, int wid, int lane) {
    unsigned char* ws = a.ws;
    const bf16* rec = (const bf16*)(ws + WS_REC); bf16* HL = (bf16*)(ws + WS_HL); bf16* PC = (bf16*)(ws + WS_PC);
    float* carA = (float*)(ws + WS_CARA); float* carB = (float*)(ws + WS_CARB); float* hmend = (float*)(ws + WS_HMEND);
    const float* conv_w = a.in[7]; const float* conv_b = a.in[8]; const float* b_rg = a.in[10]; const float* b_ig = a.in[12]; const float* lam = a.in[13];
    float* u32f = (float*)lds;
    bf16* ubf = (bf16*)(lds + 33792);
    float* segs = (float*)(lds + 33792 + 17408);
    const int g = wid & 3, th = wid >> 2, q = lane & 31, hi = lane >> 5;
    const int tau = (q & 3) | (((q >> 3) & 3) << 2) | (((q >> 2) & 1) << 4);
    int cur_n = -1; float brg = 0.f, big = 0.f, cch = 0.f;
    bf16* wl = (bf16*)(lds + 33792 + 17408 + 4096 + 2560);
    float* cwl = (float*)(lds + 33792 + 17408 + 4096);
    const int ti = tid >> 3, cg8 = tid & 7;
    bf16x8 rn[8];
#define LOAD_REC(idq) do { const bool meta_ = (idq) >= 2048; const int n_ = (idq) & 7; int b_ = 0, c_ = 0; if (!meta_) { const int bc_ = (idq) >> 3; b_ = bc_ >> 6; c_ = bc_ & 63; } \
        _Pragma("unroll") for (int jt = 0; jt < 4; ++jt) { const int tt = (meta_ ? ti : 64 * c_ + ti) - 3 + jt; int row; if (meta_) row = (tt >= 0) ? MBASE + tt : -1; else row = (tt >= 0) ? b_ * 4096 + tt : MBASE + 16 + tt; \
            if (row >= 0) { rn[2 * jt] = *(const bf16x8*)(rec + (size_t)row * 1024 + 128 * n_ + 16 * cg8); rn[2 * jt + 1] = *(const bf16x8*)(rec + (size_t)row * 1024 + 128 * n_ + 16 * cg8 + 8); } \
            else { rn[2 * jt] = (bf16x8){0, 0, 0, 0, 0, 0, 0, 0}; rn[2 * jt + 1] = (bf16x8){0, 0, 0, 0, 0, 0, 0, 0}; } } } while (0)
    if ((int)blockIdx.x < 2056) LOAD_REC((int)blockIdx.x);
    for (int id = blockIdx.x; id < 2056; id += G) {
        const bool meta = id >= 2048; const int n = id & 7; int b = 0, c = 0; if (!meta) { const int bc = id >> 3; b = bc >> 6; c = bc & 63; }
        const int ch = 128 * n + 32 * g + q;
        if (n != cur_n) {
            for (int i = tid; i < 2 * 128 * 16; i += NTHREADS) { const int gsel = i >> 11, orow = (i >> 4) & 127, pc16 = i & 15;
                const bf16* src = (const bf16*)(ws + (gsel ? WS_WIG : WS_WRG)) + ((size_t)(n * 128 + orow)) * 128 + 8 * pc16;
                *(u32x4*)(wl + (gsel * 128 + orow) * 136 + 8 * pc16) = *(const u32x4*)src; }
            brg = b_rg[ch]; big = b_ig[ch]; cch = -8.0f * 1.4426950408889634f * log1pf(expf(-lam[ch])); cur_n = n;
            for (int i = tid; i < 640; i += NTHREADS) cwl[i] = (i < 512) ? conv_w[(i >> 7) * 1024 + 128 * n + (i & 127)] : conv_b[128 * n + (i - 512)];
            __syncthreads();
        }
        {
            float u[16];
#pragma unroll
            for (int e4 = 0; e4 < 4; ++e4) { const f32x4 bb = *(const f32x4*)(cwl + 512 + 16 * cg8 + 4 * e4); u[4 * e4] = bb[0]; u[4 * e4 + 1] = bb[1]; u[4 * e4 + 2] = bb[2]; u[4 * e4 + 3] = bb[3]; }
#pragma unroll
            for (int jt = 0; jt < 4; ++jt) {
                const bf16x8 r0 = rn[2 * jt], r1 = rn[2 * jt + 1];
#pragma unroll
                for (int e4 = 0; e4 < 4; ++e4) { const f32x4 wv = *(const f32x4*)(cwl + jt * 128 + 16 * cg8 + 4 * e4);
#pragma unroll
                    for (int e = 0; e < 4; ++e) { const int idx = 4 * e4 + e; const float rv = bf2f((unsigned short)(idx < 8 ? r0[idx] : r1[idx - 8])); u[idx] += rv * wv[e]; } }
            }
            if (id + G < 2056) LOAD_REC(id + G);
#pragma unroll
            for (int e4 = 0; e4 < 4; ++e4) { f32x4 v = {u[4 * e4], u[4 * e4 + 1], u[4 * e4 + 2], u[4 * e4 + 3]}; *(f32x4*)(u32f + ti * 132 + 16 * cg8 + 4 * e4) = v; }
            u32x4 w0, w1; w0.x = pk2(u[0], u[1]); w0.y = pk2(u[2], u[3]); w0.z = pk2(u[4], u[5]); w0.w = pk2(u[6], u[7]);
            w1.x = pk2(u[8], u[9]); w1.y = pk2(u[10], u[11]); w1.z = pk2(u[12], u[13]); w1.w = pk2(u[14], u[15]);
            *(u32x4*)(ubf + ti * 136 + 16 * cg8) = w0; *(u32x4*)(ubf + ti * 136 + 16 * cg8 + 8) = w1;
        }
        LDS_BAR();
        f32x16 Dr, Di;
#pragma unroll
        for (int r = 0; r < 16; ++r) { Dr[r] = 0.f; Di[r] = 0.f; }
#pragma unroll
        for (int ks = 0; ks < 8; ++ks) { const bf16x8 af = *(const bf16x8*)(ubf + (32 * th + tau) * 136 + 16 * ks + 8 * hi);
            const bf16x8 wrv = *(const bf16x8*)(wl + (32 * g + q) * 136 + 16 * ks + 8 * hi), wiv = *(const bf16x8*)(wl + (128 + 32 * g + q) * 136 + 16 * ks + 8 * hi);
            Dr = __builtin_amdgcn_mfma_f32_32x32x16_bf16(af, wrv, Dr, 0, 0, 0); Di = __builtin_amdgcn_mfma_f32_32x32x16_bf16(af, wiv, Di, 0, 0, 0); }
        float hl[16], pc[16]; float hcur = 0.f, P = 1.f;
#pragma unroll
        for (int r = 0; r < 16; ++r) {
            const int tok = 32 * th + 16 * hi + r; const float uval = u32f[tok * 132 + 32 * g + q];
            const float rr = sigmoidf_(Dr[r] + brg), ii = sigmoidf_(Di[r] + big);
            float av = __builtin_amdgcn_exp2f(cch * rr); float bt = __builtin_amdgcn_sqrtf((1.0f - av) * (1.0f + av)) * ii * uval;
            if (meta && tok >= 16) { av = 1.f; bt = 0.f; }
            hcur = av * hcur + bt; P *= av; hl[r] = hcur; pc[r] = P;
        }
        const int seg = 2 * th + hi;
        segs[(seg * 128 + 32 * g + q) * 2] = P; segs[(seg * 128 + 32 * g + q) * 2 + 1] = hcur;
        LDS_BAR();
        float hin = 0.f, Pin = 1.f;
#pragma unroll
        for (int s = 0; s < 3; ++s) if (s < seg) { const float A_ = segs[(s * 128 + 32 * g + q) * 2], B_ = segs[(s * 128 + 32 * g + q) * 2 + 1]; hin = A_ * hin + B_; Pin *= A_; }
#pragma unroll
        for (int r = 0; r < 16; ++r) { hl[r] += pc[r] * hin; pc[r] *= Pin; }
        if (!meta) {
            bf16* hlt = (bf16*)lds; bf16* pct = (bf16*)(lds + 17408);
#pragma unroll
            for (int r = 0; r < 16; ++r) { const int o_ = (32 * th + 16 * hi + r) * 136 + 32 * g + q; hlt[o_] = (bf16)f2bf(hl[r]); pct[o_] = (bf16)f2bf(pc[r]); }
            if (seg == 3) { carA[(size_t)(b * 64 + c) * 1024 + ch] = pc[15]; carB[(size_t)(b * 64 + c) * 1024 + ch] = hl[15]; }
            LDS_BAR();
#pragma unroll
            for (int k = 0; k < 2; ++k) { const int p_ = tid + NTHREADS * k, row = p_ >> 4, cpos = (p_ & 15) * 8; const size_t go = ((size_t)b * 4096 + 64 * c + row) * 1024 + 128 * n + cpos;
                *(u32x4*)(HL + go) = *(const u32x4*)(hlt + row * 136 + cpos); *(u32x4*)(PC + go) = *(const u32x4*)(pct + row * 136 + cpos); }
        } else if (seg == 3) hmend[ch] = hl[15];
        LDS_BAR();
    }
#undef LOAD_REC
}
__device__ __forceinline__ void fixup_phase(const Args& a, unsigned char* lds, int G, int tid, int wid, int lane) {
    unsigned char* ws = a.ws;
    const bf16* HL = (const bf16*)(ws + WS_HL); const bf16* PC = (const bf16*)(ws + WS_PC); const bf16* GT = (const bf16*)(ws + WS_GATE); bf16* Y = (bf16*)(ws + WS_Y);
    const float* carA = (const float*)(ws + WS_CARA); const float* carB = (const float*)(ws + WS_CARB); const float* hmend = (const float*)(ws + WS_HMEND);
    float* cA = (float*)lds; float* cB = cA + 64 * 64; float* hin_l = cB + 64 * 64;
    for (int item = blockIdx.x; item < 256; item += G) {
        const int b = item >> 6, s16 = (item >> 2) & 15, qtr = item & 3, ch0 = 64 * s16;
        for (int i = tid; i < 64 * 64; i += NTHREADS) { const int c = i >> 6, cc = i & 63; cA[i] = carA[(size_t)(b * 64 + c) * 1024 + ch0 + cc]; cB[i] = carB[(size_t)(b * 64 + c) * 1024 + ch0 + cc]; }
        __syncthreads();
        if (wid == 0) {
            float h = hmend[ch0 + lane];
#pragma unroll 16
            for (int c = 0; c < 16 * qtr; ++c) h = cA[c * 64 + lane] * h + cB[c * 64 + lane];
#pragma unroll
            for (int cc = 0; cc < 16; ++cc) { hin_l[cc * 64 + lane] = h; const int c = 16 * qtr + cc; h = cA[c * 64 + lane] * h + cB[c * 64 + lane]; }
        }
        __syncthreads();
        const int i = tid >> 3, l8 = tid & 7;
        for (int cc0 = 0; cc0 < 16; cc0 += 4) {
            bf16x8 h8[4], p8[4], g8[4];
#pragma unroll
            for (int k = 0; k < 4; ++k) { const size_t off = ((size_t)b * 4096 + 64 * (16 * qtr + cc0 + k) + i) * 1024 + ch0 + 8 * l8;
                h8[k] = *(const bf16x8*)(HL + off); p8[k] = *(const bf16x8*)(PC + off); g8[k] = *(const bf16x8*)(GT + off); }
#pragma unroll
            for (int k = 0; k < 4; ++k) { const size_t off = ((size_t)b * 4096 + 64 * (16 * qtr + cc0 + k) + i) * 1024 + ch0 + 8 * l8;
                float y[8];
#pragma unroll
                for (int e = 0; e < 8; ++e) y[e] = (bf2f((unsigned short)h8[k][e]) + bf2f((unsigned short)p8[k][e]) * hin_l[(cc0 + k) * 64 + 8 * l8 + e]) * bf2f((unsigned short)g8[k][e]);
                u32x4 w; w.x = pk2(y[0], y[1]); w.y = pk2(y[2], y[3]); w.z = pk2(y[4], y[5]); w.w = pk2(y[6], y[7]);
                *(u32x4*)(Y + off) = w; }
        }
        __syncthreads();
    }
}
__device__ __forceinline__ void scanfix_phase(const Args& a, unsigned char* lds, int G, int tid, int wid, int lane) {
    unsigned char* ws = a.ws;
    const bf16* rec = (const bf16*)(ws + WS_REC); bf16* HL = (bf16*)(ws + WS_HL); bf16* PC = (bf16*)(ws + WS_PC);
    float* carA = (float*)(ws + WS_CARA); float* carB = (float*)(ws + WS_CARB); float* hmend = (float*)(ws + WS_HMEND);
    const float* conv_w = a.in[7]; const float* conv_b = a.in[8]; const float* b_rg = a.in[10]; const float* b_ig = a.in[12]; const float* lam = a.in[13];
    float* u32f = (float*)lds;
    bf16* ubf = (bf16*)(lds + 33792);
    float* segs = (float*)(lds + 33792 + 17408);
    const int g = wid & 3, th = wid >> 2, q = lane & 31, hi = lane >> 5;
    const int tau = (q & 3) | (((q >> 3) & 3) << 2) | (((q >> 2) & 1) << 4);
    int cur_n = -1; float brg = 0.f, big = 0.f, cch = 0.f;
    bf16* wl = (bf16*)(lds + 33792 + 17408 + 4096 + 2560);
    float* cwl = (float*)(lds + 33792 + 17408 + 4096);
    const int ti = tid >> 3, cg8 = tid & 7;
    bf16x8 rn[8];
#define LOAD_REC(idq) do { const bool meta_ = (idq) >= 2048; const int n_ = (idq) & 7; int b_ = 0, c_ = 0; if (!meta_) { const int bc_ = (idq) >> 3; b_ = bc_ >> 6; c_ = bc_ & 63; } \
        _Pragma("unroll") for (int jt = 0; jt < 4; ++jt) { const int tt = (meta_ ? ti : 64 * c_ + ti) - 3 + jt; int row; if (meta_) row = (tt >= 0) ? MBASE + tt : -1; else row = (tt >= 0) ? b_ * 4096 + tt : MBASE + 16 + tt; \
            if (row >= 0) { rn[2 * jt] = *(const bf16x8*)(rec + (size_t)row * 1024 + 128 * n_ + 16 * cg8); rn[2 * jt + 1] = *(const bf16x8*)(rec + (size_t)row * 1024 + 128 * n_ + 16 * cg8 + 8); } \
            else { rn[2 * jt] = (bf16x8){0, 0, 0, 0, 0, 0, 0, 0}; rn[2 * jt + 1] = (bf16x8){0, 0, 0, 0, 0, 0, 0, 0}; } } } while (0)
    const int wn = blockIdx.x & 7, sg = (blockIdx.x >> 3) & 7, wb = blockIdx.x >> 6;
    const int NIT = (sg == 0) ? 9 : 8;
#define SID(k_) ((sg == 0) ? ((k_) == 0 ? 2048 + wn : ((((wb * 64 + 8 * sg + (k_) - 1)) << 3) | wn)) : ((((wb * 64 + 8 * sg + (k_))) << 3) | wn))
    float* carr = (float*)(lds + 127488);
    float* hin_l = (float*)(lds + 127488 + 2048);
    if (tid < 128) { carr[2 * tid] = 1.f; carr[2 * tid + 1] = 0.f; }
    LOAD_REC(SID(0));
    for (int kk = 0; kk < NIT; ++kk) {
        const int id = SID(kk);
        const bool meta = id >= 2048; const int n = id & 7; int b = 0, c = 0; if (!meta) { const int bc = id >> 3; b = bc >> 6; c = bc & 63; }
        const int ch = 128 * n + 32 * g + q;
        if (n != cur_n) {
            for (int i = tid; i < 2 * 128 * 16; i += NTHREADS) { const int gsel = i >> 11, orow = (i >> 4) & 127, pc16 = i & 15;
                const bf16* src = (const bf16*)(ws + (gsel ? WS_WIG : WS_WRG)) + ((size_t)(n * 128 + orow)) * 128 + 8 * pc16;
                *(u32x4*)(wl + (gsel * 128 + orow) * 136 + 8 * pc16) = *(const u32x4*)src; }
            brg = b_rg[ch]; big = b_ig[ch]; cch = -8.0f * 1.4426950408889634f * log1pf(expf(-lam[ch])); cur_n = n;
            for (int i = tid; i < 640; i += NTHREADS) cwl[i] = (i < 512) ? conv_w[(i >> 7) * 1024 + 128 * n + (i & 127)] : conv_b[128 * n + (i - 512)];
            __syncthreads();
        }
        {
            float u[16];
#pragma unroll
            for (int e4 = 0; e4 < 4; ++e4) { const f32x4 bb = *(const f32x4*)(cwl + 512 + 16 * cg8 + 4 * e4); u[4 * e4] = bb[0]; u[4 * e4 + 1] = bb[1]; u[4 * e4 + 2] = bb[2]; u[4 * e4 + 3] = bb[3]; }
#pragma unroll
            for (int jt = 0; jt < 4; ++jt) {
                const bf16x8 r0 = rn[2 * jt], r1 = rn[2 * jt + 1];
#pragma unroll
                for (int e4 = 0; e4 < 4; ++e4) { const f32x4 wv = *(const f32x4*)(cwl + jt * 128 + 16 * cg8 + 4 * e4);
#pragma unroll
                    for (int e = 0; e < 4; ++e) { const int idx = 4 * e4 + e; const float rv = bf2f((unsigned short)(idx < 8 ? r0[idx] : r1[idx - 8])); u[idx] += rv * wv[e]; } }
            }
            if (kk + 1 < NIT) LOAD_REC(SID(kk + 1));
#pragma unroll
            for (int e4 = 0; e4 < 4; ++e4) { f32x4 v = {u[4 * e4], u[4 * e4 + 1], u[4 * e4 + 2], u[4 * e4 + 3]}; *(f32x4*)(u32f + ti * 132 + 16 * cg8 + 4 * e4) = v; }
            u32x4 w0, w1; w0.x = pk2(u[0], u[1]); w0.y = pk2(u[2], u[3]); w0.z = pk2(u[4], u[5]); w0.w = pk2(u[6], u[7]);
            w1.x = pk2(u[8], u[9]); w1.y = pk2(u[10], u[11]); w1.z = pk2(u[12], u[13]); w1.w = pk2(u[14], u[15]);
            *(u32x4*)(ubf + ti * 136 + 16 * cg8) = w0; *(u32x4*)(ubf + ti * 136 + 16 * cg8 + 8) = w1;
        }
        LDS_BAR();
        f32x16 Dr, Di;
#pragma unroll
        for (int r = 0; r < 16; ++r) { Dr[r] = 0.f; Di[r] = 0.f; }
#pragma unroll
        for (int ks = 0; ks < 8; ++ks) { const bf16x8 af = *(const bf16x8*)(ubf + (32 * th + tau) * 136 + 16 * ks + 8 * hi);
            const bf16x8 wrv = *(const bf16x8*)(wl + (32 * g + q) * 136 + 16 * ks + 8 * hi), wiv = *(const bf16x8*)(wl + (128 + 32 * g + q) * 136 + 16 * ks + 8 * hi);
            Dr = __builtin_amdgcn_mfma_f32_32x32x16_bf16(af, wrv, Dr, 0, 0, 0); Di = __builtin_amdgcn_mfma_f32_32x32x16_bf16(af, wiv, Di, 0, 0, 0); }
        float hl[16], pc[16]; float hcur = 0.f, P = 1.f;
#pragma unroll
        for (int r = 0; r < 16; ++r) {
            const int tok = 32 * th + 16 * hi + r; const float uval = u32f[tok * 132 + 32 * g + q];
            const float rr = sigmoidf_(Dr[r] + brg), ii = sigmoidf_(Di[r] + big);
            float av = __builtin_amdgcn_exp2f(cch * rr); float bt = __builtin_amdgcn_sqrtf((1.0f - av) * (1.0f + av)) * ii * uval;
            if (meta && tok >= 16) { av = 1.f; bt = 0.f; }
            hcur = av * hcur + bt; P *= av; hl[r] = hcur; pc[r] = P;
        }
        const int seg = 2 * th + hi;
        segs[(seg * 128 + 32 * g + q) * 2] = P; segs[(seg * 128 + 32 * g + q) * 2 + 1] = hcur;
        LDS_BAR();
        const float* cin = carr + (kk & 1) * 256;
        float hin = cin[2 * (32 * g + q) + 1], Pin = cin[2 * (32 * g + q)];
#pragma unroll
        for (int s = 0; s < 3; ++s) if (s < seg) { const float A_ = segs[(s * 128 + 32 * g + q) * 2], B_ = segs[(s * 128 + 32 * g + q) * 2 + 1]; hin = A_ * hin + B_; Pin *= A_; }
#pragma unroll
        for (int r = 0; r < 16; ++r) { hl[r] += pc[r] * hin; pc[r] *= Pin; }
        if (!meta) {
            bf16* hlt = (bf16*)lds; bf16* pct = (bf16*)(lds + 17408);
#pragma unroll
            for (int r = 0; r < 16; ++r) { const int o_ = (32 * th + 16 * hi + r) * 136 + 32 * g + q; hlt[o_] = (bf16)f2bf(hl[r]); pct[o_] = (bf16)f2bf(pc[r]); }
            LDS_BAR();
#pragma unroll
            for (int k = 0; k < 2; ++k) { const int p_ = tid + NTHREADS * k, row = p_ >> 4, cpos = (p_ & 15) * 8; const size_t go = ((size_t)b * 4096 + 64 * c + row) * 1024 + 128 * n + cpos;
                *(u32x4*)(HL + go) = *(const u32x4*)(hlt + row * 136 + cpos); *(u32x4*)(PC + go) = *(const u32x4*)(pct + row * 136 + cpos); }
        }
        if (seg == 3) { float* cout = carr + ((kk + 1) & 1) * 256; cout[2 * (32 * g + q)] = pc[15]; cout[2 * (32 * g + q) + 1] = hl[15]; }
        LDS_BAR();
    }
#undef LOAD_REC
#undef SID
    float* agg = (float*)(ws + WS_CARA);
    unsigned* sflag = (unsigned*)(ws + WS_SFLAG);
    const int strm = wb * 8 + wn;
    {
        const float* cfin = carr + (NIT & 1) * 256;
        if (tid < 256) __hip_atomic_store(agg + ((size_t)(strm * 8 + sg)) * 256 + tid, cfin[tid], __ATOMIC_RELAXED, __HIP_MEMORY_SCOPE_AGENT);
    }
    asm volatile("s_waitcnt vmcnt(0)" ::: "memory");
    __syncthreads();
    if (tid == 0) __hip_atomic_store(sflag + strm * 8 + sg, 1u, __ATOMIC_RELAXED, __HIP_MEMORY_SCOPE_AGENT);
    if (tid < sg) { unsigned spins = 0; while (__hip_atomic_load(sflag + strm * 8 + tid, __ATOMIC_RELAXED, __HIP_MEMORY_SCOPE_AGENT) != 1u) { __builtin_amdgcn_s_sleep(2); if (++spins > (1u << 22)) break; } }
    __syncthreads();
    if (tid < 128) {
        float Av[7], Bv[7];
#pragma unroll
        for (int t = 0; t < 7; ++t) { Av[t] = 1.f; Bv[t] = 0.f; if (t < sg) { Av[t] = __hip_atomic_load(agg + ((size_t)(strm * 8 + t)) * 256 + 2 * tid, __ATOMIC_RELAXED, __HIP_MEMORY_SCOPE_AGENT);
            Bv[t] = __hip_atomic_load(agg + ((size_t)(strm * 8 + t)) * 256 + 2 * tid + 1, __ATOMIC_RELAXED, __HIP_MEMORY_SCOPE_AGENT); } }
        float h = 0.f;
#pragma unroll
        for (int t = 0; t < 7; ++t) if (t < sg) h = Av[t] * h + Bv[t];
        hin_l[tid] = h;
    }
    __syncthreads();
    {
        const bf16* GT = (const bf16*)(ws + WS_GATE); bf16* Y = (bf16*)(ws + WS_Y);
        for (int cc0 = 0; cc0 < 8; cc0 += 2) {
            u32x4 hv[2][2], pv[2][2], gv[2][2];
#pragma unroll
            for (int j = 0; j < 2; ++j)
#pragma unroll
                for (int k = 0; k < 2; ++k) { const int p_ = tid + NTHREADS * k, row = p_ >> 4, cpos = (p_ & 15) * 8;
                    const size_t go = ((size_t)wb * 4096 + 64 * (8 * sg + cc0 + j) + row) * 1024 + 128 * wn + cpos;
                    hv[j][k] = *(const u32x4*)(HL + go); pv[j][k] = *(const u32x4*)(PC + go); gv[j][k] = *(const u32x4*)(GT + go); }
#pragma unroll
            for (int j = 0; j < 2; ++j)
#pragma unroll
                for (int k = 0; k < 2; ++k) { const int p_ = tid + NTHREADS * k, row = p_ >> 4, cpos = (p_ & 15) * 8;
                    const size_t go = ((size_t)wb * 4096 + 64 * (8 * sg + cc0 + j) + row) * 1024 + 128 * wn + cpos;
                    u32x4 yo;
#pragma unroll
                    for (int e = 0; e < 4; ++e) { const float h0 = hin_l[cpos + 2 * e], h1 = hin_l[cpos + 2 * e + 1];
                        yo[e] = pk2((pg8::bflo(hv[j][k][e]) + pg8::bflo(pv[j][k][e]) * h0) * pg8::bflo(gv[j][k][e]), (pg8::bfhi(hv[j][k][e]) + pg8::bfhi(pv[j][k][e]) * h1) * pg8::bfhi(gv[j][k][e])); }
                    *(u32x4*)(Y + go) = yo; }
        }
    }
}
__device__ __forceinline__ void final_norm(const Args& a, int gw, int NGW, int lane) {
    const float* rowss4 = (const float*)(a.ws + WS_ROWSS) + 4 * MALLOC; const float* gfin = a.in[17]; const bf16* hb = (const bf16*)(a.ws + WS_HB);
    const f32x4 g0 = ((const f32x4*)gfin)[2 * lane], g1 = ((const f32x4*)gfin)[2 * lane + 1], g2 = ((const f32x4*)gfin)[128 + 2 * lane], g3 = ((const f32x4*)gfin)[128 + 2 * lane + 1];
    for (int m = gw; m < NREAL; m += NGW) {
        const float rs = pg8::rstd_of(rowss4[m]); const u32x4* hp = (const u32x4*)(hb + (size_t)m * 1024) + lane; f32x4* p = (f32x4*)(a.out + (size_t)m * 1024);
        const u32x4 v0 = hp[0], v1 = hp[64];
        f32x4 o;
        o = (f32x4){pg8::bflo(v0.x), pg8::bfhi(v0.x), pg8::bflo(v0.y), pg8::bfhi(v0.y)}; p[2 * lane] = o * rs * g0;
        o = (f32x4){pg8::bflo(v0.z), pg8::bfhi(v0.z), pg8::bflo(v0.w), pg8::bfhi(v0.w)}; p[2 * lane + 1] = o * rs * g1;
        o = (f32x4){pg8::bflo(v1.x), pg8::bfhi(v1.x), pg8::bflo(v1.y), pg8::bfhi(v1.y)}; p[128 + 2 * lane] = o * rs * g2;
        o = (f32x4){pg8::bflo(v1.z), pg8::bfhi(v1.z), pg8::bflo(v1.w), pg8::bfhi(v1.w)}; p[128 + 2 * lane + 1] = o * rs * g3;
    }
}

#define XB_TMO      128
#define XB_XCNT(j)  (256  + 64 * (j))
#define XB_XSUB(j)  (1280 + 64 * (j))
#define XB_XGEN(j)  (2304 + 64 * (j))
#define XB_TOP      3328
#define XB_TOPGEN   3392
#define XCD_BAR_WORDS 3456
#define XB_SPIN_CAP (1u << 18)

__device__ __forceinline__ unsigned xb_ld(unsigned* p)              { return __hip_atomic_load(p, __ATOMIC_RELAXED, __HIP_MEMORY_SCOPE_AGENT); }
__device__ __forceinline__ unsigned xb_add(unsigned* p, unsigned v) { return __hip_atomic_fetch_add(p, v, __ATOMIC_RELAXED, __HIP_MEMORY_SCOPE_AGENT); }
__device__ __forceinline__ unsigned xb_xcc_id() { return (unsigned)__builtin_amdgcn_s_getreg((3 << 11) | 20) & 0xFu; }
#define XB_SPIN(cond, bar) do { unsigned _sp = 0; while (cond) { __builtin_amdgcn_s_sleep(1); \
    if ((++_sp & 255u) == 0u) { if (xb_ld(&(bar)[XB_TMO])) break; if (_sp > XB_SPIN_CAP) { atomicAdd(&(bar)[XB_TMO], 1u); break; } } } } while (0)

struct XcdBarrier {
    unsigned* bar; unsigned x;
    volatile LAS unsigned* st;
};

__device__ __forceinline__ XcdBarrier xcd_barrier_post(unsigned* bar, volatile LAS unsigned* st) {
    XcdBarrier b; b.bar = bar; b.x = xb_xcc_id(); b.st = st;
    if (threadIdx.x == 0) (void)xb_add(&bar[XB_XCNT(b.x)], 1u);
    return b;
}
__device__ __forceinline__ void xcd_barrier_complete(unsigned* bar, unsigned x, unsigned& nloc, unsigned& nx) {
    const unsigned G = gridDim.x * gridDim.y * gridDim.z;
    unsigned sum, cnt, mine, sp = 0u;
    for (;;) {
        sum = 0u; cnt = 0u; mine = 0u;
#pragma unroll
        for (unsigned j = 0; j < 16; ++j) { const unsigned c = xb_ld(&bar[XB_XCNT(j)]); sum += c; cnt += (c > 0u) ? 1u : 0u; mine = (j == x) ? c : mine; }
        if (sum == G) break;
        __builtin_amdgcn_s_sleep(1);
        if ((++sp & 255u) == 0u) { if (xb_ld(&bar[XB_TMO])) break; if (sp > XB_SPIN_CAP) { atomicAdd(&bar[XB_TMO], 1u); break; } }
    }
    nloc = mine > 0u ? mine : 1u; nx = cnt > 0u ? cnt : 1u;
}

__device__ __forceinline__ void xcd_barrier(const XcdBarrier& b) {
    asm volatile("s_waitcnt vmcnt(0)" ::: "memory");
    __syncthreads();
    if (threadIdx.x == 0) {
        unsigned* bar = b.bar;
        __builtin_amdgcn_s_waitcnt(0);
        unsigned nloc = b.st[0], nx = b.st[1];
        if (nloc == 0u) { xcd_barrier_complete(bar, b.x, nloc, nx); b.st[0] = nloc; b.st[1] = nx; }
        const unsigned old = xb_add(&bar[XB_XSUB(b.x)], 1u);
        const unsigned gen = old / nloc;
        if (old + 1u == (gen + 1u) * nloc) {
            __builtin_amdgcn_fence(__ATOMIC_RELEASE, "agent");
            asm volatile("s_waitcnt vmcnt(0)" ::: "memory");
            const unsigned og = xb_add(&bar[XB_TOP], 1u);
            const unsigned tg = og / nx;
            if (og + 1u == (tg + 1u) * nx) xb_add(&bar[XB_TOPGEN], 1u);
            else XB_SPIN(xb_ld(&bar[XB_TOPGEN]) == tg, bar);
            __builtin_amdgcn_fence(__ATOMIC_ACQUIRE, "agent");
            xb_add(&bar[XB_XGEN(b.x)], 1u);
            asm volatile("s_waitcnt vmcnt(0)" ::: "memory");
        } else {
            XB_SPIN(xb_ld(&bar[XB_XGEN(b.x)]) == gen, bar);
            __builtin_amdgcn_fence(__ATOMIC_ACQUIRE, "agent");
            asm volatile("s_waitcnt vmcnt(0)" ::: "memory");
        }
    }
    __syncthreads();
}

__global__ void __launch_bounds__(NTHREADS, 2) fwd_kernel(Args args) {
    extern __shared__ __attribute__((aligned(16))) unsigned char lds[];
    cg::grid_group grid = cg::this_grid();
    const int tid = threadIdx.x, lane = tid & 63, wid = __builtin_amdgcn_readfirstlane(tid >> 6);
    const int G = gridDim.x, gw = blockIdx.x * NWAVES + wid, NGW = G * NWAVES;
    unsigned char* ws = args.ws; float* rowss = (float*)(ws + WS_ROWSS); bf16* hb = (bf16*)(ws + WS_HB);
    const int lo = args.ph_lo, hi = args.ph_hi;
#define IN(k) (lo <= (k) && (k) < hi)
#ifndef PROBE_MASK
#define PROBE_MASK 0
#endif
#define REPS(k) (((PROBE_MASK >> (k)) & 1) ? 2 : 1)
#define SEAM(k) do { if (IN(k) && IN((k) + 1)) xcd_barrier(xb); } while (0)
    unsigned* barw = (unsigned*)(ws + WS_BAR); volatile LAS unsigned* st = (volatile LAS unsigned*)((LAS unsigned char*)lds + 131072 + 32);
    if (tid < 2) st[tid] = 0u;
    __syncthreads();
    if (lo < 0) grid.sync();
    XcdBarrier xb = xcd_barrier_post(barw, st);
    PG8_LAS unsigned char* ldsp = (PG8_LAS unsigned char*)lds;
    PG8_LAS float* rstl = (PG8_LAS float*)((PG8_LAS unsigned char*)lds + 131072 + 1024);
#define FILL_RST(ROWSS) int nrst_ = 0; { pg8::Unit uu_; while (nrst_ < 12 && S.next(nrst_, uu_)) { if (tid < 256) rstl[nrst_ * 256 + tid] = pg8::rstd_of((ROWSS)[uu_.pm * 256 + tid]); ++nrst_; } } __syncthreads()
    if (IN(0)) for (int rep_ = 0; rep_ < REPS(0); ++rep_) { prologue(args, lds, gw, NGW, wid, lane); } SEAM(0);
    if (IN(1)) {
        skinny_phase<SK_QKV>(args, lds, G, wid, lane);
#if defined(PROBE_SKINNY)
        skinny_phase<SK_QKV>(args, lds, G, wid, lane);
#endif
        pg8::Gemm g{hb, (const bf16*)(ws + WS_WQKV), NREAL, 3072, 1024, 1024, 1024}; pg8::StaticOrder S; S.init(NREAL, 3072, G, (int)blockIdx.x);
        FILL_RST(rowss);
        pg8::EpiQKV E{(bf16*)(ws + WS_Q), (bf16*)(ws + WS_K), (bf16*)(ws + WS_VT), rowss, QSCALE, rstl, nrst_, (PG8_LAS unsigned char*)lds + 131072 + 1024 + 12288};
        pg8::gemm_phase<pg8::EpiQKV, pg8::StaticOrder, true, true>(ldsp, g, S, E);
    } SEAM(1);
    if (IN(2)) for (int rep_ = 0; rep_ < REPS(2); ++rep_) { attn_phase((const bf16*)(ws + WS_Q), (const bf16*)(ws + WS_K), (const bf16*)(ws + WS_VT), (bf16*)(ws + WS_O), gw, NGW, lane); } SEAM(2);
    if (IN(3)) {
        skinny_phase<SK_OPROJ>(args, lds, G, wid, lane);
        pg8::Gemm g{(const bf16*)(ws + WS_O), (const bf16*)(ws + WS_WO), NREAL, 1024, 1024, 1024, 1024}; pg8::StaticOrder S; S.init(NREAL, 1024, G, (int)blockIdx.x);
        pg8::EpiResid E{hb, rowss + 1 * MALLOC};
        pg8::gemm_phase<pg8::EpiResid, pg8::StaticOrder, true, true>(ldsp, g, S, E);
    } SEAM(3);
    if (IN(4)) {
        skinny_phase<SK_UP>(args, lds, G, wid, lane);
#if defined(PROBE_SKINNY)
        skinny_phase<SK_UP>(args, lds, G, wid, lane);
#endif
        pg8::Gemm g{hb, (const bf16*)(ws + WS_WUP0), NREAL, 4096, 1024, 1024, 1024}; pg8::StaticOrder S; S.init(NREAL, 4096, G, (int)blockIdx.x);
        FILL_RST(rowss + 1 * MALLOC);
        pg8::EpiUp E{(bf16*)(ws + WS_ACT), rowss + 1 * MALLOC, rstl, nrst_};
        pg8::gemm_phase<pg8::EpiUp, pg8::StaticOrder, true, true>(ldsp, g, S, E);
    }
#if defined(PROBE_DUP4)
    if (IN(4)) {
        pg8::Gemm g{hb, (const bf16*)(ws + WS_WUP0), NREAL, 4096, 1024, 1024, 1024}; pg8::StaticOrder S; S.init(NREAL, 4096, G, (int)blockIdx.x);
        pg8::EpiUp E{(bf16*)(ws + WS_ACT), rowss + 1 * MALLOC};
        pg8::gemm_phase<pg8::EpiUp, pg8::StaticOrder, true, true>(ldsp, g, S, E);
    }
#endif
#if defined(PROBE_DUP1)
    if (IN(4)) {
        pg8::Gemm g{hb, (const bf16*)(ws + WS_WQKV), NREAL, 3072, 1024, 1024, 1024}; pg8::StaticOrder S; S.init(NREAL, 3072, G, (int)blockIdx.x);
        pg8::EpiQKV E{(bf16*)(ws + WS_Y), (bf16*)(ws + WS_Y), (bf16*)(ws + WS_Y), rowss, QSCALE};
        pg8::gemm_phase<pg8::EpiQKV, pg8::StaticOrder, true, true>(ldsp, g, S, E);
    }
#endif
    SEAM(4);
    if (IN(5)) {
        skinny_phase<SK_DOWN>(args, lds, G, wid, lane);
        pg8::Gemm g{(const bf16*)(ws + WS_ACT), (const bf16*)(ws + WS_WDN0), NREAL, 1024, 4096, ACT_LD, ACT_LD}; pg8::StaticOrder S; S.init(NREAL, 1024, G, (int)blockIdx.x);
        pg8::EpiResid E{hb, rowss + 2 * MALLOC};
        pg8::gemm_phase<pg8::EpiResid, pg8::StaticOrder, true, true>(ldsp, g, S, E);
    }
#if defined(PROBE_K4096)
    if (IN(5)) {
        pg8::Gemm g{(const bf16*)(ws + WS_ACT), (const bf16*)(ws + WS_WDN0), NREAL, 1024, 4096, ACT_LD, ACT_LD}; pg8::StaticOrder S; S.init(NREAL, 1024, G, (int)blockIdx.x);
        pg8::EpiNull E{(float*)(ws + WS_Y)};
        pg8::gemm_phase<pg8::EpiNull, pg8::StaticOrder, true, true>(ldsp, g, S, E);
    }
#endif
#if defined(PROBE_K1024)
    if (IN(5)) {
        pg8::Gemm g{hb, (const bf16*)(ws + WS_WO), NREAL, 1024, 1024, 1024, 1024}; pg8::StaticOrder S; S.init(NREAL, 1024, G, (int)blockIdx.x);
        pg8::EpiNull E{(float*)(ws + WS_Y)};
        pg8::gemm_phase<pg8::EpiNull, pg8::StaticOrder, true, true>(ldsp, g, S, E);
    }
#endif
#if defined(PROBE_UPNULL)
    if (IN(5)) {
        pg8::Gemm g{hb, (const bf16*)(ws + WS_WUP0), NREAL, 4096, 1024, 1024, 1024}; pg8::StaticOrder S; S.init(NREAL, 4096, G, (int)blockIdx.x);
        pg8::EpiNull E{(float*)(ws + WS_Y)};
        pg8::gemm_phase<pg8::EpiNull, pg8::StaticOrder, true, true>(ldsp, g, S, E);
    }
#endif
    SEAM(5);
    if (IN(6)) {
        skinny_phase<SK_WIN>(args, lds, G, wid, lane);
#if defined(PROBE_SKINNY)
        skinny_phase<SK_WIN>(args, lds, G, wid, lane);
#endif
        pg8::Gemm g{hb, (const bf16*)(ws + WS_WIN), NREAL, 2048, 1024, 1024, 1024}; pg8::StaticOrder S; S.init(NREAL, 2048, G, (int)blockIdx.x);
        FILL_RST(rowss + 2 * MALLOC);
        pg8::EpiWin E{(bf16*)(ws + WS_GATE), (bf16*)(ws + WS_REC), rowss + 2 * MALLOC, rstl, nrst_};
        pg8::gemm_phase<pg8::EpiWin, pg8::StaticOrder, true, true>(ldsp, g, S, E);
    } SEAM(6);
    if (IN(7)) { scanfix_phase(args, lds, G, tid, wid, lane); }
    SEAM(8);
    if (IN(9)) {
        pg8::Gemm g{(const bf16*)(ws + WS_Y), (const bf16*)(ws + WS_WOUT), NREAL, 1024, 1024, 1024, 1024}; pg8::StaticOrder S; S.init(NREAL, 1024, G, (int)blockIdx.x);
        pg8::EpiResid E{hb, rowss + 3 * MALLOC};
        pg8::gemm_phase<pg8::EpiResid, pg8::StaticOrder, true, true>(ldsp, g, S, E);
    } SEAM(9);
    if (IN(10)) {
        pg8::Gemm g{hb, (const bf16*)(ws + WS_WUP1), NREAL, 4096, 1024, 1024, 1024}; pg8::StaticOrder S; S.init(NREAL, 4096, G, (int)blockIdx.x);
        FILL_RST(rowss + 3 * MALLOC);
        pg8::EpiUp E{(bf16*)(ws + WS_ACT), rowss + 3 * MALLOC, rstl, nrst_};
        pg8::gemm_phase<pg8::EpiUp, pg8::StaticOrder, true, true>(ldsp, g, S, E);
    } SEAM(10);
    if (IN(11)) {
        pg8::Gemm g{(const bf16*)(ws + WS_ACT), (const bf16*)(ws + WS_WDN1), NREAL, 1024, 4096, ACT_LD, ACT_LD}; pg8::StaticOrder S; S.init(NREAL, 1024, G, (int)blockIdx.x);
        if (G == 256) {
            pg8::EpiFinal E{hb, rowss + 4 * MALLOC, args.out, args.in[17], (unsigned*)(ws + WS_PCNT)};
            pg8::gemm_phase<pg8::EpiFinal, pg8::StaticOrder, false, true>(ldsp, g, S, E);
        } else {
            pg8::EpiResid E{hb, rowss + 4 * MALLOC};
            pg8::gemm_phase<pg8::EpiResid, pg8::StaticOrder, true, true>(ldsp, g, S, E);
        }
    }
    if (G != 256) { SEAM(11); if (IN(12)) { final_norm(args, gw, NGW, lane); } }
#undef IN
#undef SEAM
}

#ifndef N_LAUNCH_MODE
#define N_LAUNCH_MODE 1
#endif
extern "C" void kernel_launch(void* const* d_in, const int* in_sizes, int n_in, void* d_out, int out_size, void* d_ws, size_t ws_size, hipStream_t stream) {
    static int grid = 0;
    if (grid == 0) {
        if (n_in != 18 || out_size != NREAL * DM || ws_size < WS_END) { fprintf(stderr, "kernel_launch: unexpected shapes (n_in %d out %d ws %zu)\n", n_in, out_size, ws_size); grid = -1; return; }
        int dev = 0, cus = 0, per_cu = 0;
        hipGetDevice(&dev); hipDeviceGetAttribute(&cus, hipDeviceAttributeMultiprocessorCount, dev);
        if (hipFuncSetAttribute((const void*)fwd_kernel, hipFuncAttributeMaxDynamicSharedMemorySize, LDS_BYTES) != hipSuccess) { fprintf(stderr, "kernel_launch: hipFuncSetAttribute failed\n"); grid = -1; return; }
        if (hipOccupancyMaxActiveBlocksPerMultiprocessor(&per_cu, (const void*)fwd_kernel, NTHREADS, LDS_BYTES) != hipSuccess || per_cu < 1) { fprintf(stderr, "kernel_launch: occupancy query gave %d\n", per_cu); per_cu = 1; }
        (void)hipGetLastError();
        grid = cus;
        if (grid != 256) { fprintf(stderr, "kernel_launch: %d CUs: the fused scan phase is laid out for 256 workgroups; nothing launched\n", grid); grid = -1; return; }
        if (grid < 96) { fprintf(stderr, "kernel_launch: %d CUs: the per-workgroup rstd table holds 12 units; nothing launched\n", grid); grid = -1; return; }
        fprintf(stderr, "kernel_launch: grid %d (cus %d, per_cu %d)\n", grid, cus, per_cu);
    }
    if (grid < 0) return;
    Args a{};
    for (int i = 0; i < 18; ++i) a.in[i] = (const float*)d_in[i];
    a.out = (float*)d_out; a.ws = (unsigned char*)d_ws;
    if (N_LAUNCH_MODE == 1) {
        a.ph_lo = 0; a.ph_hi = 13;
        if (hipMemsetAsync((unsigned char*)d_ws + WS_BAR, 0, XCD_BAR_WORDS * 4, stream) != hipSuccess) { fprintf(stderr, "kernel_launch: memset of the barrier words failed\n"); return; }
        void* kargs[] = {&a};
        hipError_t e = hipLaunchCooperativeKernel((const void*)fwd_kernel, dim3(grid), dim3(NTHREADS), kargs, LDS_BYTES, stream);
        if (e != hipSuccess) fprintf(stderr, "cooperative launch failed: %s (grid %d)\n", hipGetErrorString(e), grid);
    } else {
        for (int p = 0; p < 13; ++p) { a.ph_lo = p; a.ph_hi = p + 1; hipLaunchKernelGGL(fwd_kernel, dim3(grid), dim3(NTHREADS), LDS_BYTES, stream, a); }
    }
}
```
